# Optimizing an MI355X kernel written in HIP

```python
import jax, jax.numpy as jnp
from jax import lax
import numpy as np

D_MODEL = 1024
BATCH = 8
SEQ = 4096
DEPTH = 1

CHUNK = 64
RET_WIDTH = D_MODEL // 2
RET_HEAD_DIM = 128
RET_HEADS = RET_WIDTH // RET_HEAD_DIM
GMLP_WIDTH = D_MODEL - RET_WIDTH
GMLP_GROUP_DIM = 128
GMLP_GROUPS = GMLP_WIDTH // GMLP_GROUP_DIM
GMLP_BLOCK = 128
MIX_WIDTH = RET_WIDTH + GMLP_WIDTH
PROJ_WIDTH = 4 * RET_WIDTH + 2 * GMLP_WIDTH
D_FF = 256 * ((8 * D_MODEL + 3 * 256 - 1) // (3 * 256))
ROPE_THETA = 10000.0
EPS = 1e-6

kernel_name = "hybrid_retention_gmlp_block"


def rmsnorm(x, g):
    xf = x.astype(jnp.float32)
    y = xf * lax.rsqrt(jnp.mean(xf * xf, axis=-1, keepdims=True) + EPS)
    return (y * g.astype(jnp.float32)).astype(x.dtype)


def layernorm(x, g, b):
    xf = x.astype(jnp.float32)
    mu = jnp.mean(xf, axis=-1, keepdims=True)
    var = jnp.mean(jnp.square(xf - mu), axis=-1, keepdims=True)
    y = (xf - mu) * lax.rsqrt(var + EPS)
    return (y * g.astype(jnp.float32) + b.astype(jnp.float32)).astype(x.dtype)


def head_groupnorm(y, g):
    B, S, H, D = y.shape
    yf = y.astype(jnp.float32)
    mu = jnp.mean(yf, axis=-1, keepdims=True)
    var = jnp.mean(jnp.square(yf - mu), axis=-1, keepdims=True)
    yn = ((yf - mu) * lax.rsqrt(var + EPS)).reshape(B, S, H * D)
    return (yn * g.astype(jnp.float32)).astype(y.dtype)


def rope(x, pos):
    D = x.shape[-1]
    inv = ROPE_THETA ** (-jnp.arange(0, D, 2, dtype=jnp.float32) / D)
    ang = pos.astype(jnp.float32)[:, None] * inv[None, :]
    cos = jnp.cos(ang).astype(x.dtype)[None, :, None, :]
    sin = jnp.sin(ang).astype(x.dtype)[None, :, None, :]
    x1, x2 = x[..., : D // 2], x[..., D // 2:]
    return jnp.concatenate([x1 * cos - x2 * sin, x2 * cos + x1 * sin], axis=-1)


def retention(q, k, v):
    B, S, H, D = q.shape
    N = S // CHUNK
    dt = q.dtype
    log_gamma = jnp.log(1.0 - jnp.power(2.0, -5.0 - jnp.arange(H, dtype=jnp.float32)))
    idx = jnp.arange(CHUNK, dtype=jnp.float32)
    inner_decay = jnp.exp(log_gamma[:, None, None] * jnp.abs(idx[:, None] - idx[None, :])).astype(dt)
    k_decay = jnp.exp(log_gamma[:, None] * (CHUNK - 1 - idx)[None, :]).astype(dt)
    q_decay = jnp.exp(log_gamma[:, None] * (idx + 1)[None, :]).astype(dt)
    chunk_decay = jnp.exp(log_gamma * CHUNK).astype(dt)

    qc = (q * (D ** -0.5)).reshape(B, N, CHUNK, H, D)
    kc = k.reshape(B, N, CHUNK, H, D)
    vc = v.reshape(B, N, CHUNK, H, D)

    scores = jnp.einsum('bnihd,bnjhd->bnhij', qc, kc) * inner_decay[None, None]
    inner = jnp.einsum('bnhij,bnjhe->bnihe', scores, vc)

    kv = jnp.einsum('bnjhd,bnjhe,hj->nbhde', kc, vc, k_decay)

    def step(state, u):
        return chunk_decay[:, None, None] * state + u, state

    _, prev = lax.scan(step, jnp.zeros(kv.shape[1:], kv.dtype), kv)
    cross = jnp.einsum('bnihd,nbhde,hi->bnihe', qc, prev, q_decay)
    return (inner + cross).reshape(B, S, H, D)


def spatial_gating(u, v, w_s, b_s, ln_g, ln_b):
    B, S, _ = v.shape
    M = S // GMLP_BLOCK
    v = layernorm(v, ln_g, ln_b)
    vb = v.reshape(B, M, GMLP_BLOCK, GMLP_GROUPS, GMLP_GROUP_DIM)
    cpos = jnp.arange(GMLP_BLOCK) // CHUNK
    mask = cpos[:, None] >= cpos[None, :]
    w = jnp.where(mask[None], w_s, jnp.zeros((), w_s.dtype))
    mixed = jnp.einsum('gts,bmsgc->bmtgc', w, vb) + b_s.T[None, None, :, :, None]
    return u * mixed.reshape(B, S, GMLP_WIDTH)


def setup_inputs(seed: int = 0) -> dict:
    key = jax.random.key(seed)
    ks = jax.random.split(key, 16)
    f32 = jnp.float32
    nrm = lambda k, shape, s: jax.random.normal(k, shape, f32) * s
    return {
        "x": jax.random.normal(ks[0], (BATCH, SEQ, D_MODEL), f32),
        "norm1_g": 1.0 + nrm(ks[1], (DEPTH, D_MODEL), 0.05),
        "w_in": nrm(ks[2], (DEPTH, D_MODEL, PROJ_WIDTH), D_MODEL ** -0.5),
        "ret_gn_g": 1.0 + nrm(ks[3], (DEPTH, RET_WIDTH), 0.05),
        "gmlp_ln_g": 1.0 + nrm(ks[4], (DEPTH, GMLP_WIDTH), 0.05),
        "gmlp_ln_b": nrm(ks[5], (DEPTH, GMLP_WIDTH), 0.02),
        "w_s": nrm(ks[6], (DEPTH, GMLP_GROUPS, GMLP_BLOCK, GMLP_BLOCK), GMLP_BLOCK ** -0.5),
        "b_s": 1.0 + nrm(ks[7], (DEPTH, GMLP_GROUPS, GMLP_BLOCK), 0.1),
        "w_out": nrm(ks[8], (DEPTH, MIX_WIDTH, D_MODEL), MIX_WIDTH ** -0.5),
        "norm2_g": 1.0 + nrm(ks[9], (DEPTH, D_MODEL), 0.05),
        "w_ffn_gate": nrm(ks[10], (DEPTH, D_MODEL, D_FF), D_MODEL ** -0.5),
        "w_ffn_up": nrm(ks[11], (DEPTH, D_MODEL, D_FF), D_MODEL ** -0.5),
        "w_ffn_down": nrm(ks[12], (DEPTH, D_FF, D_MODEL), D_FF ** -0.5),
        "final_g": 1.0 + nrm(ks[13], (D_MODEL,), 0.05),
    }


def reference(x, norm1_g, w_in, ret_gn_g, gmlp_ln_g, gmlp_ln_b, w_s, b_s, w_out,
              norm2_g, w_ffn_gate, w_ffn_up, w_ffn_down, final_g):
    B, S, _ = x.shape
    pos = jnp.arange(S)
    splits = [RET_WIDTH, 2 * RET_WIDTH, 3 * RET_WIDTH, 4 * RET_WIDTH, 4 * RET_WIDTH + GMLP_WIDTH]
    for l in range(DEPTH):
        h = rmsnorm(x, norm1_g[l])
        p = h @ w_in[l]
        q, k, v, g, u, vg = jnp.split(p, splits, axis=-1)
        q = rope(q.reshape(B, S, RET_HEADS, RET_HEAD_DIM), pos)
        k = rope(k.reshape(B, S, RET_HEADS, RET_HEAD_DIM), pos)
        v = v.reshape(B, S, RET_HEADS, RET_HEAD_DIM)
        ret = head_groupnorm(retention(q, k, v), ret_gn_g[l]) * jax.nn.silu(g)
        gm = spatial_gating(jax.nn.gelu(u), jax.nn.gelu(vg), w_s[l], b_s[l],
                            gmlp_ln_g[l], gmlp_ln_b[l])
        x = x + jnp.concatenate([ret, gm], axis=-1) @ w_out[l]
        h2 = rmsnorm(x, norm2_g[l])
        x = x + (jax.nn.silu(h2 @ w_ffn_gate[l]) * (h2 @ w_ffn_up[l])) @ w_ffn_down[l]
    return rmsnorm(x, final_g)
```

```cpp
#include <hip/hip_runtime.h>
#include <hip/hip_cooperative_groups.h>
#include <cstdio>
#include <cstdint>
namespace cg = cooperative_groups;

#ifndef N_LAUNCHES
#define N_LAUNCHES 1
#endif

#define LAS __attribute__((address_space(3)))
typedef unsigned short bf16_t;
typedef short bf16x8 __attribute__((ext_vector_type(8)));
typedef float f32x4 __attribute__((ext_vector_type(4)));
typedef float f32x2 __attribute__((ext_vector_type(2)));
typedef unsigned u32x4 __attribute__((ext_vector_type(4)));
typedef unsigned u32x2 __attribute__((ext_vector_type(2)));

constexpr int BATCH = 8, SEQ = 4096, DM = 1024, M = BATCH * SEQ;
constexpr int RW = 512, HD = 128, NH = 4, GW = 512, GB = 128, NG = 4, CHUNK = 64;
constexpr int NPROJ = 3072, DFF = 2816, NFF2 = 2 * DFF;
constexpr float EPS = 1e-6f;
constexpr int NPHASE = 8;

constexpr size_t MiB = 1u << 20;
constexpr size_t WS_W1 = 2 * MiB;
constexpr size_t WS_W4 = 8 * MiB;
constexpr size_t WS_W5 = 10 * MiB;
constexpr size_t WS_W6 = 22 * MiB;
constexpr size_t WS_WS = 28 * MiB;
constexpr size_t WS_SS1 = 29 * MiB;
constexpr size_t WS_SS2 = 31 * MiB;
constexpr size_t WS_ROPE = 33 * MiB;
constexpr size_t WS_GST = 35 * MiB;
constexpr size_t WS_XN = 48 * MiB;
constexpr size_t WS_Q = 112 * MiB;
constexpr size_t WS_SEG = 32 * MiB;
constexpr size_t WS_HID = 112 * MiB;
constexpr size_t WS_MIX = 304 * MiB;
constexpr size_t WS_Y = 368 * MiB;
constexpr size_t WS_END = 432 * MiB;

constexpr int LDS_BYTES = 147456;

__device__ __forceinline__ unsigned cvt_pk_bf16(float lo, float hi) { unsigned r; asm volatile("v_cvt_pk_bf16_f32 %0, %1, %2" : "=v"(r) : "v"(lo), "v"(hi)); return r; }
__device__ __forceinline__ float bf2f(bf16_t b) { return __uint_as_float(((unsigned)b) << 16); }
__device__ __forceinline__ float bflo(unsigned w) { return __uint_as_float(w << 16); }
__device__ __forceinline__ float bfhi(unsigned w) { return __uint_as_float(w & 0xffff0000u); }
__device__ __forceinline__ float wave_sum(float v) {
#pragma unroll
    for (int o = 1; o < 64; o <<= 1) v += __shfl_xor(v, o);
    return v;
}
__device__ __forceinline__ float sigmoidf_(float x) { return __builtin_amdgcn_rcpf(1.0f + __builtin_amdgcn_exp2f(-1.4426950408889634f * x)); }
__device__ __forceinline__ float silu_(float x) { return x * sigmoidf_(x); }
__device__ __forceinline__ float gelu_(float x) { const float z = 1.5957691216057308f * (x + 0.044715f * x * x * x); return x * sigmoidf_(z); }

constexpr int BM = 256, HALF = 128, NXCD = 8, WGM = 8;
__host__ __device__ __forceinline__ int perm32(int rho) { const int n = rho >> 4, i = rho & 15; return 8 * (i >> 2) + 4 * n + (i & 3); }
struct Unit { int pm, pn; };
struct StaticOrder {
    int nM, nN, nwg, G, c;
    __host__ __device__ void init(int M_, int N_, int G_, int c_) { nM = M_ / BM; nN = N_ / BM; nwg = nM * nN; G = G_; c = c_; }
    __host__ __device__ bool next(int i, Unit& u) const {
        const long L = (long)i * G + c; if (L >= nwg) return false;
        int wgid = (int)L; { const int q = nwg / NXCD, r = nwg % NXCD, xcd = wgid % NXCD, off = wgid / NXCD; wgid = (xcd < r ? xcd * (q + 1) : r * (q + 1) + (xcd - r) * q) + off; }
        const int nig = WGM * nN, gid = wgid / nig, fm = gid * WGM, gsz = (nM - fm) < WGM ? (nM - fm) : WGM;
        u.pm = fm + ((wgid % nig) % gsz); u.pn = (wgid % nig) / gsz; return true;
    }
};

typedef f32x4 Acc[2][2][4][2];

template <class Epi>
__device__ __forceinline__ void gemm_simple(const bf16_t* __restrict__ A, const bf16_t* __restrict__ Bt, int Mr, int N, int K, int G, int c, const Epi& E) {
    const int tid = threadIdx.x, wid = tid >> 6, lane = tid & 63, wr = wid >> 2, wc = wid & 3, fr = lane & 15, fq = lane >> 4;
    StaticOrder S; S.init(Mr, N, G, c);
    Unit u;
    for (int ui = 0; S.next(ui, u); ++ui) {
        Acc acc;
#pragma unroll
        for (int a = 0; a < 2; ++a)
#pragma unroll
            for (int b = 0; b < 2; ++b)
#pragma unroll
                for (int m = 0; m < 4; ++m)
#pragma unroll
                    for (int n = 0; n < 2; ++n) acc[a][b][m][n] = (f32x4){0.f, 0.f, 0.f, 0.f};
        const bf16_t* ap = A + (size_t)(u.pm * BM + wr * 64 + fr) * K + 8 * fq;
        const bf16_t* bp0 = Bt + (size_t)(u.pn * BM + wc * 32 + perm32(fr)) * K + 8 * fq;
        const bf16_t* bp1 = Bt + (size_t)(u.pn * BM + wc * 32 + perm32(16 + fr)) * K + 8 * fq;
        for (int k0 = 0; k0 < K; k0 += 32) {
            bf16x8 At[2][4], Bf[2][2];
#pragma unroll
            for (int ai = 0; ai < 2; ++ai)
#pragma unroll
                for (int m = 0; m < 4; ++m) At[ai][m] = *(const bf16x8*)(ap + (size_t)(ai * HALF + m * 16) * K + k0);
#pragma unroll
            for (int bj = 0; bj < 2; ++bj) { Bf[bj][0] = *(const bf16x8*)(bp0 + (size_t)(bj * HALF) * K + k0); Bf[bj][1] = *(const bf16x8*)(bp1 + (size_t)(bj * HALF) * K + k0); }
#pragma unroll
            for (int ai = 0; ai < 2; ++ai)
#pragma unroll
                for (int bj = 0; bj < 2; ++bj)
#pragma unroll
                    for (int m = 0; m < 4; ++m)
#pragma unroll
                        for (int n = 0; n < 2; ++n) acc[ai][bj][m][n] = __builtin_amdgcn_mfma_f32_16x16x32_bf16(Bf[bj][n], At[ai][m], acc[ai][bj][m][n], 0, 0, 0);
        }
        E(acc, u, wr, wc, fr, fq);
    }
}

__device__ __forceinline__ void store8(bf16_t* p, const f32x4& a, const f32x4& b) {
    u32x4 w; w.x = cvt_pk_bf16(a[0], a[1]); w.y = cvt_pk_bf16(a[2], a[3]); w.z = cvt_pk_bf16(b[0], b[1]); w.w = cvt_pk_bf16(b[2], b[3]);
    *(u32x4*)p = w;
}
struct EpiProj {
    bf16_t* qkv;
    const f32x2* rope;
    __device__ __forceinline__ void operator()(const Acc& acc, const Unit& u, int wr, int wc, int fr, int fq) const {
        const int kind = u.pn >> 1, halfsel = u.pn & 1;
        bf16_t* dst = qkv + (size_t)kind * (WS_SEG / 2);
        const int row0 = u.pm * BM + wr * 64 + fr;
        if (kind < 2) {
            const float sc = (kind == 0) ? 0.08838834764831845f : 1.0f;
            const int hh = wc >> 1, i0 = 32 * (wc & 1) + 8 * fq;
            const int cbase = halfsel * 256 + hh * 128 + i0;
#pragma unroll
            for (int ai = 0; ai < 2; ++ai)
#pragma unroll
                for (int m = 0; m < 4; ++m) {
                    const int r = row0 + ai * HALF + m * 16, pos = r & (SEQ - 1);
                    const f32x4* tp = (const f32x4*)(rope + (size_t)pos * 64 + i0);
                    const f32x4 t0 = tp[0], t1 = tp[1], t2 = tp[2], t3 = tp[3];
                    const f32x4 xa0 = acc[ai][0][m][0], xa1 = acc[ai][0][m][1], xb0 = acc[ai][1][m][0], xb1 = acc[ai][1][m][1];
                    f32x4 o10, o11, o20, o21;
                    o10[0] = (xa0[0] * t0[0] - xb0[0] * t0[1]) * sc; o20[0] = (xb0[0] * t0[0] + xa0[0] * t0[1]) * sc;
                    o10[1] = (xa0[1] * t0[2] - xb0[1] * t0[3]) * sc; o20[1] = (xb0[1] * t0[2] + xa0[1] * t0[3]) * sc;
                    o10[2] = (xa0[2] * t1[0] - xb0[2] * t1[1]) * sc; o20[2] = (xb0[2] * t1[0] + xa0[2] * t1[1]) * sc;
                    o10[3] = (xa0[3] * t1[2] - xb0[3] * t1[3]) * sc; o20[3] = (xb0[3] * t1[2] + xa0[3] * t1[3]) * sc;
                    o11[0] = (xa1[0] * t2[0] - xb1[0] * t2[1]) * sc; o21[0] = (xb1[0] * t2[0] + xa1[0] * t2[1]) * sc;
                    o11[1] = (xa1[1] * t2[2] - xb1[1] * t2[3]) * sc; o21[1] = (xb1[1] * t2[2] + xa1[1] * t2[3]) * sc;
                    o11[2] = (xa1[2] * t3[0] - xb1[2] * t3[1]) * sc; o21[2] = (xb1[2] * t3[0] + xa1[2] * t3[1]) * sc;
                    o11[3] = (xa1[3] * t3[2] - xb1[3] * t3[3]) * sc; o21[3] = (xb1[3] * t3[2] + xa1[3] * t3[3]) * sc;
                    bf16_t* rp = dst + (size_t)r * RW + cbase;
                    store8(rp, o10, o11); store8(rp + 64, o20, o21);
                }
        } else {
            const int cbase = halfsel * 256 + wc * 32 + 8 * fq;
#pragma unroll
            for (int ai = 0; ai < 2; ++ai)
#pragma unroll
                for (int m = 0; m < 4; ++m) {
                    bf16_t* rp = dst + (size_t)(row0 + ai * HALF + m * 16) * RW + cbase;
#pragma unroll
                    for (int bj = 0; bj < 2; ++bj) {
                        f32x4 v0 = acc[ai][bj][m][0], v1 = acc[ai][bj][m][1];
                        if (kind == 3) {
#pragma unroll
                            for (int j = 0; j < 4; ++j) { v0[j] = silu_(v0[j]); v1[j] = silu_(v1[j]); }
                        } else if (kind >= 4) {
#pragma unroll
                            for (int j = 0; j < 4; ++j) { v0[j] = gelu_(v0[j]); v1[j] = gelu_(v1[j]); }
                        }
                        store8(rp + bj * HALF, v0, v1);
                    }
                }
        }
    }
};
struct EpiResid {
    const float* base; float* out; bf16_t* outb; float* ss;
    __device__ __forceinline__ void operator()(const Acc& acc, const Unit& u, int wr, int wc, int fr, int fq) const {
        const int row0 = u.pm * BM + wr * 64 + fr, col0 = u.pn * BM + wc * 32 + 8 * fq;
#pragma unroll
        for (int ai = 0; ai < 2; ++ai)
#pragma unroll
            for (int m = 0; m < 4; ++m) {
                const int r = row0 + ai * HALF + m * 16; const size_t off = (size_t)r * DM + col0; float q = 0.f;
#pragma unroll
                for (int bj = 0; bj < 2; ++bj) {
                    const f32x4 b0 = *(const f32x4*)(base + off + bj * HALF), b1 = *(const f32x4*)(base + off + bj * HALF + 4);
                    const f32x4 v0 = acc[ai][bj][m][0] + b0, v1 = acc[ai][bj][m][1] + b1;
                    *(f32x4*)(out + off + bj * HALF) = v0; *(f32x4*)(out + off + bj * HALF + 4) = v1;
                    if (outb) store8(outb + off + bj * HALF, v0, v1);
                    q += (v0[0] * v0[0] + v0[1] * v0[1]) + (v0[2] * v0[2] + v0[3] * v0[3]) + (v1[0] * v1[0] + v1[1] * v1[1]) + (v1[2] * v1[2] + v1[3] * v1[3]);
                }
                q += __shfl_xor(q, 16); q += __shfl_xor(q, 32);
                if (fq == 0) ss[(size_t)(u.pn * 4 + wc) * M + r] = q;
            }
    }
};
__device__ __forceinline__ float row_rstd(const float* ss, int r) {
    float s = 0.f;
#pragma unroll
    for (int t = 0; t < 16; ++t) s += ss[(size_t)t * M + r];
    return 1.0f / sqrtf(s * (1.0f / DM) + EPS);
}
struct EpiSwiglu {
    bf16_t* hid; const float* ss;
    __device__ __forceinline__ void operator()(const Acc& acc, const Unit& u, int wr, int wc, int fr, int fq) const {
        const int row0 = u.pm * BM + wr * 64 + fr, col0 = u.pn * HALF + wc * 32 + 8 * fq;
#pragma unroll
        for (int ai = 0; ai < 2; ++ai)
#pragma unroll
            for (int m = 0; m < 4; ++m) {
                const int r = row0 + ai * HALF + m * 16; const float rs = row_rstd(ss, r);
                f32x4 h0, h1;
#pragma unroll
                for (int j = 0; j < 4; ++j) { h0[j] = silu_(acc[ai][0][m][0][j] * rs) * (acc[ai][1][m][0][j] * rs); h1[j] = silu_(acc[ai][0][m][1][j] * rs) * (acc[ai][1][m][1][j] * rs); }
                store8(hid + (size_t)r * DFF + col0, h0, h1);
            }
    }
};

__device__ __forceinline__ void transpose_item(const float* __restrict__ W, int ldw, int srccol0, int k0, const float* __restrict__ kscale, bf16_t* __restrict__ WT, int K, int dstrow0, LAS float* scr, int lane) {
#pragma unroll 8
    for (int i = 0; i < 32; ++i) { const int kk = 2 * i + (lane >> 5); float v = W[(size_t)(k0 + kk) * ldw + srccol0 + (lane & 31)]; if (kscale) v *= kscale[k0 + kk]; scr[kk * 33 + (lane & 31)] = v; }
    asm volatile("s_waitcnt lgkmcnt(0)" ::: "memory");
    const int c = lane & 7;
#pragma unroll
    for (int j = 0; j < 4; ++j) { const int n = (lane >> 3) + 8 * j; const LAS float* s = scr + (8 * c) * 33 + n;
        u32x4 o; o.x = cvt_pk_bf16(s[0 * 33], s[1 * 33]); o.y = cvt_pk_bf16(s[2 * 33], s[3 * 33]); o.z = cvt_pk_bf16(s[4 * 33], s[5 * 33]); o.w = cvt_pk_bf16(s[6 * 33], s[7 * 33]);
        *(u32x4*)(WT + (size_t)(dstrow0 + n) * K + k0 + 8 * c) = o; }
    asm volatile("s_waitcnt lgkmcnt(0)" ::: "memory");
}
__device__ __forceinline__ void sincos_d(double ang, float& s, float& c) {
    const double k = rint(ang * 0.63661977236758134308);
    const double r = fma(-k, 1.57079632679489661923, ang);
    const int q = (int)(((long long)k) & 3);
    const float x = (float)r, x2 = x * x;
    const float sp = x * (1.0f + x2 * (-1.6666667e-1f + x2 * (8.3333333e-3f + x2 * (-1.9841270e-4f + x2 * 2.7557319e-6f))));
    const float cp = 1.0f + x2 * (-0.5f + x2 * (4.1666667e-2f + x2 * (-1.3888889e-3f + x2 * (2.4801587e-5f + x2 * (-2.7557319e-7f)))));
    s = (q == 0) ? sp : (q == 1) ? cp : (q == 2) ? -sp : -cp;
    c = (q == 0) ? cp : (q == 1) ? -sp : (q == 2) ? -cp : sp;
}

struct Params {
    const float* in[14];
    float* out;
    unsigned char* ws;
    int ph_lo, ph_hi;
};

__device__ __forceinline__ void p0_prologue(const Params& p, LAS unsigned char* lds, int G, int bid) {
    const int tid = threadIdx.x, lane = tid & 63, wave = tid >> 6;
    const int gw = bid * 8 + wave, NGW = G * 8;
    LAS float* scr = (LAS float*)(lds + wave * 16384);
    const float* x = p.in[0]; const float* g1 = p.in[1]; const float* w_in = p.in[2];
    const float* w_s = p.in[6]; const float* w_out = p.in[8]; const float* g2 = p.in[9];
    const float* wg = p.in[10]; const float* wu = p.in[11]; const float* wd = p.in[12];
    bf16_t* W1 = (bf16_t*)(p.ws + WS_W1); bf16_t* W4 = (bf16_t*)(p.ws + WS_W4); bf16_t* W5 = (bf16_t*)(p.ws + WS_W5); bf16_t* W6 = (bf16_t*)(p.ws + WS_W6);
    constexpr int I1 = 16 * (NPROJ / 32), I4 = 16 * (DM / 32), I5 = 16 * (NFF2 / 32), I6 = (DFF / 64) * (DM / 32);
    for (int it = gw; it < I1 + I4 + I5 + I6; it += NGW) {
        int r = it;
        if (r < I1) { const int nb = r % (NPROJ / 32), kb = r / (NPROJ / 32), n0 = 32 * nb; int src = n0;
            if (n0 < 1024) { const int pn = n0 >> 8, pp = n0 & 255, bj = pp >> 7, rr = pp & 127, hh = rr >> 6, i = rr & 63; src = 256 * pn + 128 * hh + 64 * bj + i; }
            transpose_item(w_in, NPROJ, src, 64 * kb, nullptr, W1, DM, n0, scr, lane); continue; }
        r -= I1;
        if (r < I4) { const int nb = r % (DM / 32), kb = r / (DM / 32); transpose_item(w_out, DM, 32 * nb, 64 * kb, nullptr, W4, DM, 32 * nb, scr, lane); continue; }
        r -= I4;
        if (r < I5) { const int nb = r % (NFF2 / 32), kb = r / (NFF2 / 32), n0 = 32 * nb, pn = n0 >> 8, pp = n0 & 255, bj = pp >> 7, rr = pp & 127;
            transpose_item(bj ? wu : wg, DFF, 128 * pn + rr, 64 * kb, g2, W5, DM, n0, scr, lane); continue; }
        r -= I5;
        { const int nb = r % (DM / 32), kb = r / (DM / 32); transpose_item(wd, DM, 32 * nb, 64 * kb, nullptr, W6, DFF, 32 * nb, scr, lane); }
    }
    { bf16_t* WSb = (bf16_t*)(p.ws + WS_WS);
      for (int i = bid * 512 + tid; i < NG * GB * GB / 2; i += G * 512) { const int e = 2 * i, s = e & 127, t = (e >> 7) & 127; float a = w_s[e], b = w_s[e + 1]; if (t < 64 && s >= 64) { a = 0.f; b = 0.f; } ((unsigned*)WSb)[i] = cvt_pk_bf16(a, b); } }
    { f32x2* tab = (f32x2*)(p.ws + WS_ROPE);
      for (int i = bid * 512 + tid; i < SEQ * 64; i += G * 512) { const int pos = i >> 6, k = i & 63;
          const double inv = exp(-(double)k * (9.210340371976184 / 64.0));
          float s, c; sincos_d((double)pos * inv, s, c); tab[i] = (f32x2){c, s}; } }
    { bf16_t* XN = (bf16_t*)(p.ws + WS_XN);
      f32x4 gv[4];
#pragma unroll
      for (int j = 0; j < 4; ++j) gv[j] = ((const f32x4*)g1)[lane + 64 * j];
      for (int m = gw; m < M; m += NGW) {
          const f32x4* xr = (const f32x4*)(x + (size_t)m * DM) + lane; f32x4 v[4]; float s = 0.f;
#pragma unroll
          for (int j = 0; j < 4; ++j) { v[j] = xr[64 * j]; s += (v[j][0] * v[j][0] + v[j][1] * v[j][1]) + (v[j][2] * v[j][2] + v[j][3] * v[j][3]); }
          const float rstd = 1.0f / sqrtf(wave_sum(s) * (1.0f / DM) + EPS);
          u32x2* o = (u32x2*)(XN + (size_t)m * DM) + lane;
#pragma unroll
          for (int j = 0; j < 4; ++j) { u32x2 w; w.x = cvt_pk_bf16(v[j][0] * rstd * gv[j][0], v[j][1] * rstd * gv[j][1]); w.y = cvt_pk_bf16(v[j][2] * rstd * gv[j][2], v[j][3] * rstd * gv[j][3]); o[64 * j] = w; }
      } }
}

__device__ __forceinline__ void p2_gstats(const Params& p, int G, int bid) {
    const int tid = threadIdx.x, lane = tid & 63, wave = tid >> 6, gw = bid * 8 + wave, NGW = G * 8;
    const bf16_t* GV = (const bf16_t*)(p.ws + WS_Q + 5 * WS_SEG); f32x2* st = (f32x2*)(p.ws + WS_GST);
    for (int m = gw; m < M; m += NGW) {
        const u32x4 w = ((const u32x4*)(GV + (size_t)m * GW))[lane];
        float v[8] = {bflo(w.x), bfhi(w.x), bflo(w.y), bfhi(w.y), bflo(w.z), bfhi(w.z), bflo(w.w), bfhi(w.w)};
        float s = 0.f;
#pragma unroll
        for (int j = 0; j < 8; ++j) s += v[j];
        const float mean = wave_sum(s) * (1.0f / GW); float q = 0.f;
#pragma unroll
        for (int j = 0; j < 8; ++j) { const float d = v[j] - mean; q += d * d; }
        const float rstd = 1.0f / sqrtf(wave_sum(q) * (1.0f / GW) + EPS);
        if (lane == 0) st[m] = (f32x2){mean, rstd};
    }
}
__device__ __forceinline__ void p2_ret_naive(const Params& p, LAS unsigned char* lds, int G, int bid) {
    const int tid = threadIdx.x;
    const bf16_t* Q = (const bf16_t*)(p.ws + WS_Q); const bf16_t* Kb = (const bf16_t*)(p.ws + WS_Q + WS_SEG); const bf16_t* Vb = (const bf16_t*)(p.ws + WS_Q + 2 * WS_SEG);
    float* Y = (float*)(p.ws + WS_Y);
    LAS float* qs = (LAS float*)lds; LAS float* ks = qs + 64 * 129; LAS float* vs = ks + 64 * 129; LAS float* Ss = vs + 64 * 128;
    const int i = tid >> 3, eg = tid & 7;
    for (int item = bid; item < BATCH * NH * 64; item += G) {
        const int n = item & 63, bh = item >> 6, h = bh & 3, b = bh >> 2;
        const float l2g = log2f(1.0f - exp2f(-5.0f - (float)h));
        const size_t row0 = (size_t)b * SEQ + n * 64;
        __syncthreads();
        for (int idx = tid; idx < 64 * 128; idx += 512) { const int ii = idx >> 7, d = idx & 127; qs[ii * 129 + d] = bf2f(Q[(row0 + ii) * RW + h * HD + d]); }
        float acc[16];
#pragma unroll
        for (int e = 0; e < 16; ++e) acc[e] = 0.f;
        for (int mm = 0; mm <= n; ++mm) {
            const size_t rk0 = (size_t)b * SEQ + mm * 64;
            __syncthreads();
            for (int idx = tid; idx < 64 * 128; idx += 512) { const int jj = idx >> 7, d = idx & 127; ks[jj * 129 + d] = bf2f(Kb[(rk0 + jj) * RW + h * HD + d]); vs[jj * 128 + d] = bf2f(Vb[(rk0 + jj) * RW + h * HD + d]); }
            __syncthreads();
#pragma unroll 1
            for (int jj = 0; jj < 8; ++jj) { const int j = eg + 8 * jj; float dot = 0.f;
#pragma unroll 16
                for (int d = 0; d < 128; ++d) dot += qs[i * 129 + d] * ks[j * 129 + d];
                int dist = 64 * (n - mm) + i - j; dist = dist < 0 ? -dist : dist;
                Ss[i * 65 + j] = dot * exp2f(l2g * (float)dist); }
            __syncthreads();
#pragma unroll 4
            for (int j = 0; j < 64; ++j) { const float s = Ss[i * 65 + j];
#pragma unroll
                for (int e = 0; e < 16; ++e) acc[e] += s * vs[j * 128 + e * 8 + eg]; }
        }
#pragma unroll
        for (int e = 0; e < 16; ++e) Y[(row0 + i) * RW + h * HD + e * 8 + eg] = acc[e];
    }
}

__device__ __forceinline__ void p3_gn_gate(const Params& p, int G, int bid) {
    const int tid = threadIdx.x, lane = tid & 63, wave = tid >> 6, gw = bid * 8 + wave, NGW = G * 8;
    const float* Y = (const float*)(p.ws + WS_Y); const bf16_t* SG = (const bf16_t*)(p.ws + WS_Q + 3 * WS_SEG); bf16_t* MIX = (bf16_t*)(p.ws + WS_MIX);
    const float* gn = p.in[3];
    const f32x4 g0 = ((const f32x4*)gn)[2 * lane], g1 = ((const f32x4*)gn)[2 * lane + 1];
    for (int m = gw; m < M; m += NGW) {
        const f32x4 a = ((const f32x4*)(Y + (size_t)m * RW))[2 * lane], b = ((const f32x4*)(Y + (size_t)m * RW))[2 * lane + 1];
        float s = (a[0] + a[1]) + (a[2] + a[3]) + (b[0] + b[1]) + (b[2] + b[3]);
        s += __shfl_xor(s, 1); s += __shfl_xor(s, 2); s += __shfl_xor(s, 4); s += __shfl_xor(s, 8);
        const float mean = s * (1.0f / HD);
        const f32x4 da = a - mean, db = b - mean;
        float q = (da[0] * da[0] + da[1] * da[1]) + (da[2] * da[2] + da[3] * da[3]) + (db[0] * db[0] + db[1] * db[1]) + (db[2] * db[2] + db[3] * db[3]);
        q += __shfl_xor(q, 1); q += __shfl_xor(q, 2); q += __shfl_xor(q, 4); q += __shfl_xor(q, 8);
        const float rstd = 1.0f / sqrtf(q * (1.0f / HD) + EPS);
        const u32x4 sg = ((const u32x4*)(SG + (size_t)m * RW))[lane];
        f32x4 o0, o1;
        o0[0] = da[0] * rstd * g0[0] * bflo(sg.x); o0[1] = da[1] * rstd * g0[1] * bfhi(sg.x); o0[2] = da[2] * rstd * g0[2] * bflo(sg.y); o0[3] = da[3] * rstd * g0[3] * bfhi(sg.y);
        o1[0] = db[0] * rstd * g1[0] * bflo(sg.z); o1[1] = db[1] * rstd * g1[1] * bfhi(sg.z); o1[2] = db[2] * rstd * g1[2] * bflo(sg.w); o1[3] = db[3] * rstd * g1[3] * bfhi(sg.w);
        store8(MIX + (size_t)m * DM + 8 * lane, o0, o1);
    }
}
__device__ __forceinline__ void p3_gmlp_naive(const Params& p, LAS unsigned char* lds, int G, int bid) {
    const int tid = threadIdx.x;
    const bf16_t* GU = (const bf16_t*)(p.ws + WS_Q + 4 * WS_SEG); const bf16_t* GV = (const bf16_t*)(p.ws + WS_Q + 5 * WS_SEG);
    const f32x2* st = (const f32x2*)(p.ws + WS_GST); bf16_t* MIX = (bf16_t*)(p.ws + WS_MIX);
    const float* lng = p.in[4]; const float* lnb = p.in[5]; const float* w_s = p.in[6]; const float* b_s = p.in[7];
    LAS float* vn = (LAS float*)lds; LAS float* wl = vn + 128 * 128;
    const int c = tid & 127, tg = tid >> 7;
    for (int item = bid; item < (M / GB) * NG; item += G) {
        const int g = item & 3, blk = item >> 2; const size_t rb = (size_t)blk * GB; const int ch = g * 128 + c;
        __syncthreads();
        const float lg = lng[ch], lb = lnb[ch];
        for (int s = tg; s < 128; s += 4) { const f32x2 ms = st[rb + s]; vn[s * 128 + c] = (bf2f(GV[(rb + s) * GW + ch]) - ms[0]) * ms[1] * lg + lb; }
        for (int idx = tid; idx < 128 * 128; idx += 512) wl[idx] = w_s[(size_t)g * 128 * 128 + idx];
        __syncthreads();
        for (int tt = 0; tt < 32; ++tt) { const int t = tg * 32 + tt; const int smax = (t < 64) ? 64 : 128; float sum = 0.f;
            for (int s = 0; s < smax; ++s) sum += wl[t * 128 + s] * vn[s * 128 + c];
            const float mixed = sum + b_s[g * 128 + t];
            const float o = bf2f(GU[(rb + t) * GW + ch]) * mixed;
            MIX[(rb + t) * DM + RW + ch] = (bf16_t)(cvt_pk_bf16(o, 0.f) & 0xffffu); }
    }
}

__device__ __forceinline__ void p7_final(const Params& p, int G, int bid) {
    const int tid = threadIdx.x, lane = tid & 63, wave = tid >> 6, gw = bid * 8 + wave, NGW = G * 8;
    const float* ss = (const float*)(p.ws + WS_SS2); const float* fg = p.in[13];
    f32x4 gv[4];
#pragma unroll
    for (int j = 0; j < 4; ++j) gv[j] = ((const f32x4*)fg)[lane + 64 * j];
    for (int m = gw; m < M; m += NGW) {
        const float rs = row_rstd(ss, m);
        f32x4* xr = (f32x4*)(p.out + (size_t)m * DM) + lane;
#pragma unroll
        for (int j = 0; j < 4; ++j) { f32x4 v = xr[64 * j]; v = v * rs * gv[j]; xr[64 * j] = v; }
    }
}

__global__ void __launch_bounds__(512, 2) fwd_kernel(Params p) {
    extern __shared__ __attribute__((aligned(16))) unsigned char lds_raw[];
    LAS unsigned char* lds = (LAS unsigned char*)lds_raw;
    const int G = gridDim.x, bid = blockIdx.x;
    unsigned char* ws = p.ws;
    const int lo = p.ph_lo, hi = p.ph_hi;
#define IN(k) (lo <= (k) && (k) < hi)
#define SEAM(k) do { if (IN(k) && IN((k) + 1)) cg::this_grid().sync(); } while (0)
    if (IN(0)) { p0_prologue(p, lds, G, bid); }
    SEAM(0);
    if (IN(1)) { EpiProj E{(bf16_t*)(ws + WS_Q), (const f32x2*)(ws + WS_ROPE)};
                 gemm_simple((const bf16_t*)(ws + WS_XN), (const bf16_t*)(ws + WS_W1), M, NPROJ, DM, G, bid, E); }
    SEAM(1);
    if (IN(2)) { p2_gstats(p, G, bid); p2_ret_naive(p, lds, G, bid); }
    SEAM(2);
    if (IN(3)) { p3_gn_gate(p, G, bid); p3_gmlp_naive(p, lds, G, bid); }
    SEAM(3);
    if (IN(4)) { EpiResid E{p.in[0], p.out, (bf16_t*)(ws + WS_XN), (float*)(ws + WS_SS1)};
                 gemm_simple((const bf16_t*)(ws + WS_MIX), (const bf16_t*)(ws + WS_W4), M, DM, DM, G, bid, E); }
    SEAM(4);
    if (IN(5)) { EpiSwiglu E{(bf16_t*)(ws + WS_HID), (const float*)(ws + WS_SS1)};
                 gemm_simple((const bf16_t*)(ws + WS_XN), (const bf16_t*)(ws + WS_W5), M, NFF2, DM, G, bid, E); }
    SEAM(5);
    if (IN(6)) { EpiResid E{p.out, p.out, nullptr, (float*)(ws + WS_SS2)};
                 gemm_simple((const bf16_t*)(ws + WS_HID), (const bf16_t*)(ws + WS_W6), M, DM, DFF, G, bid, E); }
    SEAM(6);
    if (IN(7)) { p7_final(p, G, bid); }
#undef IN
#undef SEAM
}

extern "C" void kernel_launch(void* const* d_in, const int* in_sizes, int n_in, void* d_out, int out_size, void* d_ws, size_t ws_size, hipStream_t stream) {
    static int grid = 0;
    if (grid == 0) {
        if (n_in != 14 || in_sizes[0] != M * DM || out_size != M * DM || ws_size < WS_END) { fprintf(stderr, "kernel_launch: unexpected shapes (n_in %d, in0 %d, out %d, ws %zu)\n", n_in, n_in > 0 ? in_sizes[0] : -1, out_size, ws_size); grid = -1; return; }
        int dev = 0, cus = 0, per_cu = 0;
        (void)hipGetDevice(&dev); (void)hipDeviceGetAttribute(&cus, hipDeviceAttributeMultiprocessorCount, dev);
        (void)hipFuncSetAttribute((const void*)fwd_kernel, hipFuncAttributeMaxDynamicSharedMemorySize, LDS_BYTES);
        (void)hipOccupancyMaxActiveBlocksPerMultiprocessor(&per_cu, (const void*)fwd_kernel, 512, LDS_BYTES);
        if (per_cu < 1) { fprintf(stderr, "kernel_launch: occupancy query says %d blocks per CU\n", per_cu); per_cu = 1; }
        if (per_cu > 1) per_cu = 1;
        grid = cus * per_cu;
        (void)hipGetLastError();
    }
    if (grid < 0) return;
    Params p{};
    for (int i = 0; i < 14; ++i) p.in[i] = (const float*)d_in[i];
    p.out = (float*)d_out; p.ws = (unsigned char*)d_ws;
    const int per = NPHASE / N_LAUNCHES;
    for (int li = 0; li < N_LAUNCHES; ++li) {
        p.ph_lo = li * per; p.ph_hi = (li == N_LAUNCHES - 1) ? NPHASE : (li + 1) * per;
        void* args[] = {&p};
        hipError_t e = hipLaunchCooperativeKernel((const void*)fwd_kernel, dim3(grid), dim3(512), args, LDS_BYTES, stream);
        if (e != hipSuccess) { fprintf(stderr, "kernel_launch: cooperative launch %d failed: %s (grid %d)\n", li, hipGetErrorString(e), grid); break; }
    }
}
```

```cpp
#include <hip/hip_runtime.h>
#include <hip/hip_cooperative_groups.h>
#include <cstdio>
#include <cstdint>
namespace cg = cooperative_groups;

#ifndef N_LAUNCHES
#define N_LAUNCHES 1
#endif

#define LAS __attribute__((address_space(3)))
typedef unsigned short bf16_t;
typedef short bf16x8 __attribute__((ext_vector_type(8)));
typedef float f32x4 __attribute__((ext_vector_type(4)));
typedef float f32x2 __attribute__((ext_vector_type(2)));
typedef unsigned u32x4 __attribute__((ext_vector_type(4)));
typedef unsigned u32x2 __attribute__((ext_vector_type(2)));

constexpr int BATCH = 8, SEQ = 4096, DM = 1024, M = BATCH * SEQ;
constexpr int RW = 512, HD = 128, NH = 4, GW = 512, GB = 128, NG = 4, CHUNK = 64;
constexpr int NPROJ = 3072, DFF = 2816, NFF2 = 2 * DFF;
constexpr float EPS = 1e-6f;
constexpr int NPHASE = 8;

constexpr size_t MiB = 1u << 20;
constexpr size_t WS_W1 = 2 * MiB;
constexpr size_t WS_W4 = 8 * MiB;
constexpr size_t WS_W5 = 10 * MiB;
constexpr size_t WS_W6 = 22 * MiB;
constexpr size_t WS_WS = 28 * MiB;
constexpr size_t WS_SS1 = 29 * MiB;
constexpr size_t WS_SS2 = 31 * MiB;
constexpr size_t WS_ROPE = 33 * MiB;
constexpr size_t WS_GST = 35 * MiB;
constexpr size_t WS_XN = 48 * MiB;
constexpr size_t WS_Q = 112 * MiB;
constexpr size_t WS_SEG = 32 * MiB;
constexpr size_t WS_HID = 112 * MiB;
constexpr size_t WS_MIX = 304 * MiB;
constexpr size_t WS_Y = 368 * MiB;
constexpr size_t WS_END = 432 * MiB;

constexpr int LDS_BYTES = 147456;

typedef __bf16 bf16x2_t __attribute__((ext_vector_type(2)));
__device__ __forceinline__ unsigned cvt_pk_bf16(float lo, float hi) { bf16x2_t v = {(__bf16)lo, (__bf16)hi}; return __builtin_bit_cast(unsigned, v); }
__device__ __forceinline__ float bf2f(bf16_t b) { return __uint_as_float(((unsigned)b) << 16); }
__device__ __forceinline__ float bflo(unsigned w) { return __uint_as_float(w << 16); }
__device__ __forceinline__ float bfhi(unsigned w) { return __uint_as_float(w & 0xffff0000u); }
__device__ __forceinline__ float wave_sum(float v) {
#pragma unroll
    for (int o = 1; o < 64; o <<= 1) v += __shfl_xor(v, o);
    return v;
}
__device__ __forceinline__ float sigmoidf_(float x) { return __builtin_amdgcn_rcpf(1.0f + __builtin_amdgcn_exp2f(-1.4426950408889634f * x)); }
__device__ __forceinline__ float silu_(float x) { return x * sigmoidf_(x); }
__device__ __forceinline__ float gelu_(float x) { const float z = 1.5957691216057308f * (x + 0.044715f * x * x * x); return x * sigmoidf_(z); }

#define PG8_LAS LAS
constexpr int BM = 256, BK = 64, HALF = 128, HTB = HALF * BK * 2  , STAGE_BYTES = 8 * HTB, NXCD = 8, WGM = 8;

__host__ __device__ __forceinline__ int lds_byte(int r, int c) { const int st = (r >> 4) * 2 + (c >> 5), rr = r & 15, cc = c & 31, ob = rr * 64 + cc * 2; return st * 1024 + (ob ^ (((ob >> 9) & 1) << 5)); }
__host__ __device__ __forceinline__ void stage_rc(int b, int& R, int& C) { const int st = b / 1024, sb = b % 1024, swz = sb ^ (((sb >> 9) & 1) << 5); R = (st >> 1) * 16 + swz / 64; C = (st & 1) * 32 + (swz % 64) / 2; }
__host__ __device__ __forceinline__ int perm32(int rho) { const int n = rho >> 4, i = rho & 15; return 8 * (i >> 2) + 4 * n + (i & 3); }
struct Unit { int pm, pn; };
struct StaticOrder {
    int nM, nN, nwg, G, c;
    __host__ __device__ void init(int M_, int N_, int G_, int c_) { nM = M_ / BM; nN = N_ / BM; nwg = nM * nN; G = G_; c = c_; }
    __host__ __device__ bool next(int i, Unit& u) const {
        const long L = (long)i * G + c; if (L >= nwg) return false;
        int wgid = (int)L; { const int q = nwg / NXCD, r = nwg % NXCD, xcd = wgid % NXCD, off = wgid / NXCD; wgid = (xcd < r ? xcd * (q + 1) : r * (q + 1) + (xcd - r) * q) + off; }
        const int nig = WGM * nN, gid = wgid / nig, fm = gid * WGM, gsz = (nM - fm) < WGM ? (nM - fm) : WGM;
        u.pm = fm + ((wgid % nig) % gsz); u.pn = (wgid % nig) / gsz; return true;
    }
    __device__ __forceinline__ void a_ready(const Unit&) const {}
    __device__ __forceinline__ void done(const Unit&) const {}
};
struct Gemm { const bf16_t* A; const bf16_t* Bt; int M, N, K; };

typedef f32x4 Acc[2][2][4][2];

template <class Epi, class Sched, bool ALIGN_EPI = false, bool SP2 = false>
__device__ __forceinline__ void gemm_phase(PG8_LAS unsigned char* lds, const Gemm g, const Sched& S, const Epi& E) {
    const int tid = threadIdx.x, wid = __builtin_amdgcn_readfirstlane(tid >> 6), lane = tid & 63, wr = wid >> 2, wc = wid & 3, fr = lane & 15, fq = lane >> 4;
    const int K = g.K, nt = K / BK;
    unsigned voffA[2], voffB[2];
#pragma unroll
    for (int i = 0; i < 2; ++i) { int R, C; stage_rc(tid * 16 + i * 8192, R, C); const int Rb = Epi::PERM ? ((R & ~31) + perm32(R & 31)) : R;
        voffA[i] = (unsigned)(R * K + C) * 2u; voffB[i] = (unsigned)(Rb * K + C) * 2u; }
    const size_t kstep = (size_t)(BK * 2);
    const size_t hstep = (size_t)HALF * K * 2;
    const size_t tstep = 2 * hstep;
    const unsigned ldsw = (unsigned)wid * 1024u;
    const int aoff = lds_byte(wr * 64 + fr, fq * 8), boff = lds_byte(wc * 32 + fr, fq * 8);
#define PG8_SA(b, h) (((b) * 2 + (h)) * HTB)
#define PG8_SB(b, h) ((4 + (b) * 2 + (h)) * HTB)
#define PG8_STAGE(bufoff, gbase, voff) do { _Pragma("unroll") for (int _i = 0; _i < 2; ++_i) \
        __builtin_amdgcn_global_load_lds((const unsigned*)((const char*)(gbase) + (voff)[_i]), (PG8_LAS unsigned*)(lds + (bufoff) + ldsw + _i * 8192), 16, 0, 0); } while (0)
#define PG8_LDA(dst, b, h) do { _Pragma("unroll") for (int m = 0; m < 4; ++m) _Pragma("unroll") for (int k = 0; k < 2; ++k) dst[m][k] = *(const PG8_LAS bf16x8*)(lds + PG8_SA(b, h) + aoff + m * 2048 + k * 1024); } while (0)
#define PG8_LDB(dst, b, h) do { _Pragma("unroll") for (int n = 0; n < 2; ++n) _Pragma("unroll") for (int k = 0; k < 2; ++k) dst[n][k] = *(const PG8_LAS bf16x8*)(lds + PG8_SB(b, h) + boff + n * 2048 + k * 1024); } while (0)
#define PG8_MMA(ai, bj, At, Bt) do { __builtin_amdgcn_s_setprio(1); _Pragma("unroll") for (int m = 0; m < 4; ++m) _Pragma("unroll") for (int n = 0; n < 2; ++n) _Pragma("unroll") for (int k = 0; k < 2; ++k) \
        acc[ai][bj][m][n] = __builtin_amdgcn_mfma_f32_16x16x32_bf16(Bt[n][k], At[m][k], acc[ai][bj][m][n], 0, 0, 0); __builtin_amdgcn_s_setprio(0); } while (0)
#define PG8_WAIT_V(n) asm volatile("s_waitcnt vmcnt(" #n ")" ::: "memory")
#define PG8_WAIT_L(n) asm volatile("s_waitcnt lgkmcnt(" #n ")" ::: "memory")
#define PG8_BAR __builtin_amdgcn_s_barrier()
#define PG8_SCHED __builtin_amdgcn_sched_barrier(0)
    Unit cur, nxt; int ui = 0;
    if (!S.next(0, cur)) return;
    f32x4 acc[2][2][4][2];
#pragma unroll
    for (int a = 0; a < 2; ++a)
#pragma unroll
        for (int b = 0; b < 2; ++b)
#pragma unroll
            for (int m = 0; m < 4; ++m)
#pragma unroll
                for (int n = 0; n < 2; ++n) acc[a][b][m][n] = (f32x4){0.f, 0.f, 0.f, 0.f};
    bf16x8 At[4][2], B0[2][2], B1[2][2];
    const char* cA = (const char*)g.A + (size_t)cur.pm * tstep; const char* cB = (const char*)g.Bt + (size_t)cur.pn * tstep;
    S.a_ready(cur);
    if constexpr (SP2) {
        PG8_STAGE(PG8_SB(0, 0), cB, voffB); PG8_STAGE(PG8_SB(0, 1), cB + hstep, voffB); PG8_STAGE(PG8_SA(0, 0), cA, voffA); PG8_STAGE(PG8_SA(0, 1), cA + hstep, voffA);
        if (wr == 1) PG8_BAR;
        PG8_WAIT_V(2); PG8_BAR;
        PG8_STAGE(PG8_SB(1, 0), cB + kstep, voffB); PG8_STAGE(PG8_SA(1, 0), cA + kstep, voffA); PG8_STAGE(PG8_SB(1, 1), cB + hstep + kstep, voffB);
        PG8_WAIT_V(6); PG8_BAR;
    } else {
        PG8_STAGE(PG8_SB(0, 0), cB, voffB); PG8_STAGE(PG8_SA(0, 0), cA, voffA); PG8_STAGE(PG8_SB(0, 1), cB + hstep, voffB); PG8_STAGE(PG8_SA(0, 1), cA + hstep, voffA);
        if (wr == 1) PG8_BAR;
        PG8_WAIT_V(4); PG8_BAR;
        PG8_STAGE(PG8_SB(1, 0), cB + kstep, voffB); PG8_STAGE(PG8_SA(1, 0), cA + kstep, voffA); PG8_STAGE(PG8_SB(1, 1), cB + hstep + kstep, voffB);
        PG8_WAIT_V(6); PG8_BAR;
    }
    for (;;) {
        const bool has_next = S.next(ui + 1, nxt);
        const char* nA = has_next ? (const char*)g.A + (size_t)nxt.pm * tstep : cA; const char* nB = has_next ? (const char*)g.Bt + (size_t)nxt.pn * tstep : cB;
        for (int t = 0; t < nt; t += 2) {
            const bool last = (t == nt - 2);
            const char* a1 = cA + (size_t)(t + 1) * kstep;
            const char* a2 = last ? nA : cA + (size_t)(t + 2) * kstep; const char* b2 = last ? nB : cB + (size_t)(t + 2) * kstep;
            const char* a3 = a2 + kstep; const char* b3 = b2 + kstep;
            if (last && has_next) S.a_ready(nxt);
            if constexpr (SP2) {
            PG8_LDB(B0, 0, 0); PG8_LDB(B1, 0, 1); PG8_SCHED; PG8_LDA(At, 0, 0); PG8_STAGE(PG8_SA(1, 1), a1 + hstep, voffA);
            PG8_WAIT_V(8); PG8_WAIT_L(0); PG8_BAR; PG8_MMA(0, 0, At, B0); PG8_MMA(0, 1, At, B1); PG8_BAR; PG8_SCHED;
            PG8_LDA(At, 0, 1); PG8_STAGE(PG8_SB(0, 0), b2, voffB); PG8_STAGE(PG8_SB(0, 1), b2 + hstep, voffB); PG8_STAGE(PG8_SA(0, 0), a2, voffA);
            PG8_WAIT_V(8); PG8_WAIT_L(0); PG8_BAR; PG8_MMA(1, 0, At, B0); PG8_MMA(1, 1, At, B1); PG8_BAR; PG8_SCHED;
            PG8_LDB(B0, 1, 0); PG8_LDB(B1, 1, 1); PG8_SCHED; PG8_LDA(At, 1, 0); PG8_STAGE(PG8_SA(0, 1), a2 + hstep, voffA);
            PG8_WAIT_V(8); PG8_WAIT_L(0); PG8_BAR; PG8_MMA(0, 0, At, B0); PG8_MMA(0, 1, At, B1); PG8_BAR; PG8_SCHED;
            PG8_LDA(At, 1, 1); PG8_STAGE(PG8_SB(1, 0), b3, voffB); PG8_STAGE(PG8_SB(1, 1), b3 + hstep, voffB); PG8_STAGE(PG8_SA(1, 0), a3, voffA);
            PG8_WAIT_V(8); PG8_WAIT_L(0); PG8_BAR; PG8_MMA(1, 0, At, B0); PG8_MMA(1, 1, At, B1); PG8_BAR; PG8_SCHED;
            } else {
            PG8_LDB(B0, 0, 0); PG8_SCHED; PG8_LDA(At, 0, 0); PG8_STAGE(PG8_SA(1, 1), a1 + hstep, voffA);
            PG8_WAIT_L(8); PG8_BAR; PG8_WAIT_L(0); PG8_MMA(0, 0, At, B0); PG8_BAR; PG8_SCHED;
            PG8_LDB(B1, 0, 1); PG8_STAGE(PG8_SB(0, 0), b2, voffB);
            PG8_BAR; PG8_WAIT_L(0); PG8_MMA(0, 1, At, B1); PG8_BAR;
            PG8_LDA(At, 0, 1); PG8_STAGE(PG8_SA(0, 0), a2, voffA);
            PG8_BAR; PG8_WAIT_L(0); PG8_MMA(1, 0, At, B0); PG8_BAR; PG8_SCHED;
            PG8_STAGE(PG8_SB(0, 1), b2 + hstep, voffB);
            PG8_WAIT_V(6); PG8_BAR; PG8_MMA(1, 1, At, B1); PG8_BAR;
            PG8_LDB(B0, 1, 0); PG8_SCHED; PG8_LDA(At, 1, 0); PG8_STAGE(PG8_SA(0, 1), a2 + hstep, voffA);
            PG8_WAIT_L(8); PG8_BAR; PG8_WAIT_L(0); PG8_MMA(0, 0, At, B0); PG8_BAR; PG8_SCHED;
            PG8_LDB(B1, 1, 1); PG8_STAGE(PG8_SB(1, 0), b3, voffB);
            PG8_BAR; PG8_WAIT_L(0); PG8_MMA(0, 1, At, B1); PG8_BAR;
            PG8_LDA(At, 1, 1); PG8_STAGE(PG8_SA(1, 0), a3, voffA);
            PG8_BAR; PG8_WAIT_L(0); PG8_MMA(1, 0, At, B0); PG8_BAR; PG8_SCHED;
            PG8_STAGE(PG8_SB(1, 1), b3 + hstep, voffB);
            PG8_WAIT_V(6); PG8_BAR; PG8_MMA(1, 1, At, B1); PG8_BAR;
            }
        }
        if constexpr (ALIGN_EPI) { if (wr == 0) PG8_BAR; }
        if constexpr (!Epi::AFTER_DRAIN) { E(acc, cur, wr, wc, fr, fq); S.done(cur); }
        if (!has_next) break;
#pragma unroll
        for (int a = 0; a < 2; ++a)
#pragma unroll
            for (int b = 0; b < 2; ++b)
#pragma unroll
                for (int m = 0; m < 4; ++m)
#pragma unroll
                    for (int n = 0; n < 2; ++n) acc[a][b][m][n] = (f32x4){0.f, 0.f, 0.f, 0.f};
        cur = nxt; cA = nA; cB = nB; ++ui;
        if constexpr (ALIGN_EPI) { if (wr == 1) PG8_BAR; }
    }
    PG8_WAIT_V(0);
    if constexpr (!ALIGN_EPI) { if (wr == 0) PG8_BAR; }
    PG8_BAR;
    if constexpr (Epi::AFTER_DRAIN) { E.fused(acc, cur, wr, wc, fr, fq, lds, wid, lane); S.done(cur); }
#undef PG8_SA
#undef PG8_SB
#undef PG8_STAGE
#undef PG8_LDA
#undef PG8_LDB
#undef PG8_MMA
#undef PG8_WAIT_V
#undef PG8_WAIT_L
#undef PG8_BAR
#undef PG8_SCHED
}

__device__ __forceinline__ void store8(bf16_t* p, const f32x4& a, const f32x4& b) {
    u32x4 w; w.x = cvt_pk_bf16(a[0], a[1]); w.y = cvt_pk_bf16(a[2], a[3]); w.z = cvt_pk_bf16(b[0], b[1]); w.w = cvt_pk_bf16(b[2], b[3]);
    *(u32x4*)p = w;
}
struct EpiProj {
    static constexpr bool PERM = true, AFTER_DRAIN = false;
    bf16_t* qkv;
    const f32x2* rope;
    __device__ __forceinline__ void operator()(const Acc& acc, const Unit& u, int wr, int wc, int fr, int fq) const {
        const int kind = u.pn >> 1, halfsel = u.pn & 1;
        bf16_t* dst = qkv + (size_t)kind * (WS_SEG / 2);
        const int row0 = u.pm * BM + wr * 64 + fr;
        if (kind < 2) {
            const int hh = wc >> 1, i0 = 32 * (wc & 1) + 8 * fq;
            const float l2g = __builtin_log2f(1.0f - __builtin_exp2f(-5.0f - (float)(2 * halfsel + hh)));
            const int cbase = halfsel * 256 + hh * 128 + i0;
#pragma unroll
            for (int ai = 0; ai < 2; ++ai)
#pragma unroll
                for (int m = 0; m < 4; ++m) {
                    const int r = row0 + ai * HALF + m * 16, pos = r & (SEQ - 1), ic = pos & (CHUNK - 1);
                    const float sc = (kind == 0) ? __builtin_amdgcn_exp2f(l2g * (float)(ic + 1)) * 0.08838834764831845f : __builtin_amdgcn_exp2f(l2g * (float)(CHUNK - 1 - ic));
                    const f32x4* tp = (const f32x4*)(rope + (size_t)pos * 64 + i0);
                    const f32x4 t0 = tp[0], t1 = tp[1], t2 = tp[2], t3 = tp[3];
                    const f32x4 xa0 = acc[ai][0][m][0], xa1 = acc[ai][0][m][1], xb0 = acc[ai][1][m][0], xb1 = acc[ai][1][m][1];
                    f32x4 o10, o11, o20, o21;
                    o10[0] = (xa0[0] * t0[0] - xb0[0] * t0[1]) * sc; o20[0] = (xb0[0] * t0[0] + xa0[0] * t0[1]) * sc;
                    o10[1] = (xa0[1] * t0[2] - xb0[1] * t0[3]) * sc; o20[1] = (xb0[1] * t0[2] + xa0[1] * t0[3]) * sc;
                    o10[2] = (xa0[2] * t1[0] - xb0[2] * t1[1]) * sc; o20[2] = (xb0[2] * t1[0] + xa0[2] * t1[1]) * sc;
                    o10[3] = (xa0[3] * t1[2] - xb0[3] * t1[3]) * sc; o20[3] = (xb0[3] * t1[2] + xa0[3] * t1[3]) * sc;
                    o11[0] = (xa1[0] * t2[0] - xb1[0] * t2[1]) * sc; o21[0] = (xb1[0] * t2[0] + xa1[0] * t2[1]) * sc;
                    o11[1] = (xa1[1] * t2[2] - xb1[1] * t2[3]) * sc; o21[1] = (xb1[1] * t2[2] + xa1[1] * t2[3]) * sc;
                    o11[2] = (xa1[2] * t3[0] - xb1[2] * t3[1]) * sc; o21[2] = (xb1[2] * t3[0] + xa1[2] * t3[1]) * sc;
                    o11[3] = (xa1[3] * t3[2] - xb1[3] * t3[3]) * sc; o21[3] = (xb1[3] * t3[2] + xa1[3] * t3[3]) * sc;
                    bf16_t* rp = dst + (size_t)r * RW + cbase;
                    store8(rp, o10, o11); store8(rp + 64, o20, o21);
                }
        } else {
            const int cbase = halfsel * 256 + wc * 32 + 8 * fq;
#pragma unroll
            for (int ai = 0; ai < 2; ++ai)
#pragma unroll
                for (int m = 0; m < 4; ++m) {
                    bf16_t* rp = dst + (size_t)(row0 + ai * HALF + m * 16) * RW + cbase;
#pragma unroll
                    for (int bj = 0; bj < 2; ++bj) {
                        f32x4 v0 = acc[ai][bj][m][0], v1 = acc[ai][bj][m][1];
                        if (kind == 3) {
#pragma unroll
                            for (int j = 0; j < 4; ++j) { v0[j] = silu_(v0[j]); v1[j] = silu_(v1[j]); }
                        } else if (kind >= 4) {
#pragma unroll
                            for (int j = 0; j < 4; ++j) { v0[j] = gelu_(v0[j]); v1[j] = gelu_(v1[j]); }
                        }
                        store8(rp + bj * HALF, v0, v1);
                    }
                }
        }
    }
};
struct EpiResid {
    static constexpr bool PERM = true, AFTER_DRAIN = false;
    const float* base; float* out; bf16_t* outb; float* ss;
    __device__ __forceinline__ void operator()(const Acc& acc, const Unit& u, int wr, int wc, int fr, int fq) const {
        const int row0 = u.pm * BM + wr * 64 + fr, col0 = u.pn * BM + wc * 32 + 8 * fq;
#pragma unroll
        for (int ai = 0; ai < 2; ++ai)
#pragma unroll
            for (int m = 0; m < 4; ++m) {
                const int r = row0 + ai * HALF + m * 16; const size_t off = (size_t)r * DM + col0; float q = 0.f;
#pragma unroll
                for (int bj = 0; bj < 2; ++bj) {
                    const f32x4 b0 = *(const f32x4*)(base + off + bj * HALF), b1 = *(const f32x4*)(base + off + bj * HALF + 4);
                    const f32x4 v0 = acc[ai][bj][m][0] + b0, v1 = acc[ai][bj][m][1] + b1;
                    *(f32x4*)(out + off + bj * HALF) = v0; *(f32x4*)(out + off + bj * HALF + 4) = v1;
                    if (outb) store8(outb + off + bj * HALF, v0, v1);
                    q += (v0[0] * v0[0] + v0[1] * v0[1]) + (v0[2] * v0[2] + v0[3] * v0[3]) + (v1[0] * v1[0] + v1[1] * v1[1]) + (v1[2] * v1[2] + v1[3] * v1[3]);
                }
                q += __shfl_xor(q, 16); q += __shfl_xor(q, 32);
                if (fq == 0) ss[(size_t)(u.pn * 4 + wc) * M + r] = q;
            }
    }
};
__device__ __forceinline__ float row_rstd(const float* ss, int r) {
    float s = 0.f;
#pragma unroll
    for (int t = 0; t < 16; ++t) s += ss[(size_t)t * M + r];
    return 1.0f / sqrtf(s * (1.0f / DM) + EPS);
}
struct EpiSwiglu {
    static constexpr bool PERM = true, AFTER_DRAIN = false;
    bf16_t* hid; const float* ss;
    __device__ __forceinline__ void operator()(const Acc& acc, const Unit& u, int wr, int wc, int fr, int fq) const {
        const int row0 = u.pm * BM + wr * 64 + fr, col0 = u.pn * HALF + wc * 32 + 8 * fq;
#pragma unroll
        for (int ai = 0; ai < 2; ++ai)
#pragma unroll
            for (int m = 0; m < 4; ++m) {
                const int r = row0 + ai * HALF + m * 16; const float rs = row_rstd(ss, r);
                f32x4 h0, h1;
#pragma unroll
                for (int j = 0; j < 4; ++j) { h0[j] = silu_(acc[ai][0][m][0][j] * rs) * (acc[ai][1][m][0][j] * rs); h1[j] = silu_(acc[ai][0][m][1][j] * rs) * (acc[ai][1][m][1][j] * rs); }
                store8(hid + (size_t)r * DFF + col0, h0, h1);
            }
    }
};

__device__ __forceinline__ void transpose_item(const float* __restrict__ W, int ldw, int srccol0, int k0, const float* __restrict__ kscale, bf16_t* __restrict__ WT, int K, int dstrow0, LAS float* scr, int lane) {
#pragma unroll 8
    for (int i = 0; i < 32; ++i) { const int kk = 2 * i + (lane >> 5); float v = W[(size_t)(k0 + kk) * ldw + srccol0 + (lane & 31)]; if (kscale) v *= kscale[k0 + kk]; scr[kk * 33 + (lane & 31)] = v; }
    asm volatile("s_waitcnt lgkmcnt(0)" ::: "memory");
    const int c = lane & 7;
#pragma unroll
    for (int j = 0; j < 4; ++j) { const int n = (lane >> 3) + 8 * j; const LAS float* s = scr + (8 * c) * 33 + n;
        u32x4 o; o.x = cvt_pk_bf16(s[0 * 33], s[1 * 33]); o.y = cvt_pk_bf16(s[2 * 33], s[3 * 33]); o.z = cvt_pk_bf16(s[4 * 33], s[5 * 33]); o.w = cvt_pk_bf16(s[6 * 33], s[7 * 33]);
        *(u32x4*)(WT + (size_t)(dstrow0 + n) * K + k0 + 8 * c) = o; }
    asm volatile("s_waitcnt lgkmcnt(0)" ::: "memory");
}
__device__ __forceinline__ void sincos_d(double ang, float& s, float& c) {
    const double k = rint(ang * 0.63661977236758134308);
    const double r = fma(-k, 1.57079632679489661923, ang);
    const int q = (int)(((long long)k) & 3);
    const float x = (float)r, x2 = x * x;
    const float sp = x * (1.0f + x2 * (-1.6666667e-1f + x2 * (8.3333333e-3f + x2 * (-1.9841270e-4f + x2 * 2.7557319e-6f))));
    const float cp = 1.0f + x2 * (-0.5f + x2 * (4.1666667e-2f + x2 * (-1.3888889e-3f + x2 * (2.4801587e-5f + x2 * (-2.7557319e-7f)))));
    s = (q == 0) ? sp : (q == 1) ? cp : (q == 2) ? -sp : -cp;
    c = (q == 0) ? cp : (q == 1) ? -sp : (q == 2) ? -cp : sp;
}

struct Params {
    const float* in[14];
    float* out;
    unsigned char* ws;
    int ph_lo, ph_hi;
};

__device__ __forceinline__ void p0_prologue(const Params& p, LAS unsigned char* lds, int G, int bid) {
    const int tid = threadIdx.x, lane = tid & 63, wave = tid >> 6;
    const int gw = bid * 8 + wave, NGW = G * 8;
    LAS float* scr = (LAS float*)(lds + wave * 16384);
    const float* x = p.in[0]; const float* g1 = p.in[1]; const float* w_in = p.in[2];
    const float* w_s = p.in[6]; const float* w_out = p.in[8]; const float* g2 = p.in[9];
    const float* wg = p.in[10]; const float* wu = p.in[11]; const float* wd = p.in[12];
    bf16_t* W1 = (bf16_t*)(p.ws + WS_W1); bf16_t* W4 = (bf16_t*)(p.ws + WS_W4); bf16_t* W5 = (bf16_t*)(p.ws + WS_W5); bf16_t* W6 = (bf16_t*)(p.ws + WS_W6);
    constexpr int I1 = 16 * (NPROJ / 32), I4 = 16 * (DM / 32), I5 = 16 * (NFF2 / 32), I6 = (DFF / 64) * (DM / 32);
    for (int it = gw; it < I1 + I4 + I5 + I6; it += NGW) {
        int r = it;
        if (r < I1) { const int nb = r % (NPROJ / 32), kb = r / (NPROJ / 32), n0 = 32 * nb; int src = n0;
            if (n0 < 1024) { const int pn = n0 >> 8, pp = n0 & 255, bj = pp >> 7, rr = pp & 127, hh = rr >> 6, i = rr & 63; src = 256 * pn + 128 * hh + 64 * bj + i; }
            transpose_item(w_in, NPROJ, src, 64 * kb, nullptr, W1, DM, n0, scr, lane); continue; }
        r -= I1;
        if (r < I4) { const int nb = r % (DM / 32), kb = r / (DM / 32); transpose_item(w_out, DM, 32 * nb, 64 * kb, nullptr, W4, DM, 32 * nb, scr, lane); continue; }
        r -= I4;
        if (r < I5) { const int nb = r % (NFF2 / 32), kb = r / (NFF2 / 32), n0 = 32 * nb, pn = n0 >> 8, pp = n0 & 255, bj = pp >> 7, rr = pp & 127;
            transpose_item(bj ? wu : wg, DFF, 128 * pn + rr, 64 * kb, g2, W5, DM, n0, scr, lane); continue; }
        r -= I5;
        { const int nb = r % (DM / 32), kb = r / (DM / 32); transpose_item(wd, DM, 32 * nb, 64 * kb, nullptr, W6, DFF, 32 * nb, scr, lane); }
    }
    { bf16_t* WSb = (bf16_t*)(p.ws + WS_WS);
      for (int i = bid * 512 + tid; i < NG * GB * GB / 2; i += G * 512) { const int e = 2 * i, s = e & 127, t = (e >> 7) & 127; float a = w_s[e], b = w_s[e + 1]; if (t < 64 && s >= 64) { a = 0.f; b = 0.f; } ((unsigned*)WSb)[i] = cvt_pk_bf16(a, b); } }
    { f32x2* tab = (f32x2*)(p.ws + WS_ROPE);
      for (int i = bid * 512 + tid; i < SEQ * 64; i += G * 512) { const int pos = i >> 6, k = i & 63;
          const double inv = exp(-(double)k * (9.210340371976184 / 64.0));
          float s, c; sincos_d((double)pos * inv, s, c); tab[i] = (f32x2){c, s}; } }
    { bf16_t* XN = (bf16_t*)(p.ws + WS_XN);
      f32x4 gv[4];
#pragma unroll
      for (int j = 0; j < 4; ++j) gv[j] = ((const f32x4*)g1)[lane + 64 * j];
      for (int m = gw; m < M; m += NGW) {
          const f32x4* xr = (const f32x4*)(x + (size_t)m * DM) + lane; f32x4 v[4]; float s = 0.f;
#pragma unroll
          for (int j = 0; j < 4; ++j) { v[j] = xr[64 * j]; s += (v[j][0] * v[j][0] + v[j][1] * v[j][1]) + (v[j][2] * v[j][2] + v[j][3] * v[j][3]); }
          const float rstd = 1.0f / sqrtf(wave_sum(s) * (1.0f / DM) + EPS);
          u32x2* o = (u32x2*)(XN + (size_t)m * DM) + lane;
#pragma unroll
          for (int j = 0; j < 4; ++j) { u32x2 w; w.x = cvt_pk_bf16(v[j][0] * rstd * gv[j][0], v[j][1] * rstd * gv[j][1]); w.y = cvt_pk_bf16(v[j][2] * rstd * gv[j][2], v[j][3] * rstd * gv[j][3]); o[64 * j] = w; }
      } }
}

__device__ __forceinline__ void p2_gstats(const Params& p, int G, int bid) {
    const int tid = threadIdx.x, lane = tid & 63, wave = tid >> 6, gw = bid * 8 + wave, NGW = G * 8;
    const bf16_t* GV = (const bf16_t*)(p.ws + WS_Q + 5 * WS_SEG); f32x2* st = (f32x2*)(p.ws + WS_GST);
    for (int m = gw; m < M; m += NGW) {
        const u32x4 w = ((const u32x4*)(GV + (size_t)m * GW))[lane];
        float v[8] = {bflo(w.x), bfhi(w.x), bflo(w.y), bfhi(w.y), bflo(w.z), bfhi(w.z), bflo(w.w), bfhi(w.w)};
        float s = 0.f;
#pragma unroll
        for (int j = 0; j < 8; ++j) s += v[j];
        const float mean = wave_sum(s) * (1.0f / GW); float q = 0.f;
#pragma unroll
        for (int j = 0; j < 8; ++j) { const float d = v[j] - mean; q += d * d; }
        const float rstd = 1.0f / sqrtf(wave_sum(q) * (1.0f / GW) + EPS);
        if (lane == 0) st[m] = (f32x2){mean, rstd};
    }
}
__device__ __forceinline__ void p2_ret_naive(const Params& p, LAS unsigned char* lds, int G, int bid) {
    const int tid = threadIdx.x;
    const bf16_t* Q = (const bf16_t*)(p.ws + WS_Q); const bf16_t* Kb = (const bf16_t*)(p.ws + WS_Q + WS_SEG); const bf16_t* Vb = (const bf16_t*)(p.ws + WS_Q + 2 * WS_SEG);
    float* Y = (float*)(p.ws + WS_Y);
    LAS float* qs = (LAS float*)lds; LAS float* ks = qs + 64 * 129; LAS float* vs = ks + 64 * 129; LAS float* Ss = vs + 64 * 128;
    const int i = tid >> 3, eg = tid & 7;
    for (int item = bid; item < BATCH * NH * 64; item += G) {
        const int n = item & 63, bh = item >> 6, h = bh & 3, b = bh >> 2;
        const float l2g = log2f(1.0f - exp2f(-5.0f - (float)h));
        const size_t row0 = (size_t)b * SEQ + n * 64;
        __syncthreads();
        for (int idx = tid; idx < 64 * 128; idx += 512) { const int ii = idx >> 7, d = idx & 127; qs[ii * 129 + d] = bf2f(Q[(row0 + ii) * RW + h * HD + d]); }
        float acc[16];
#pragma unroll
        for (int e = 0; e < 16; ++e) acc[e] = 0.f;
        for (int mm = 0; mm <= n; ++mm) {
            const size_t rk0 = (size_t)b * SEQ + mm * 64;
            __syncthreads();
            for (int idx = tid; idx < 64 * 128; idx += 512) { const int jj = idx >> 7, d = idx & 127; ks[jj * 129 + d] = bf2f(Kb[(rk0 + jj) * RW + h * HD + d]); vs[jj * 128 + d] = bf2f(Vb[(rk0 + jj) * RW + h * HD + d]); }
            __syncthreads();
#pragma unroll 1
            for (int jj = 0; jj < 8; ++jj) { const int j = eg + 8 * jj; float dot = 0.f;
#pragma unroll 16
                for (int d = 0; d < 128; ++d) dot += qs[i * 129 + d] * ks[j * 129 + d];
                int dist = 64 * (n - mm) + i - j; dist = dist < 0 ? -dist : dist;
                Ss[i * 65 + j] = dot * exp2f(l2g * (float)(dist - (i + 1) - (63 - j))); }
            __syncthreads();
#pragma unroll 4
            for (int j = 0; j < 64; ++j) { const float s = Ss[i * 65 + j];
#pragma unroll
                for (int e = 0; e < 16; ++e) acc[e] += s * vs[j * 128 + e * 8 + eg]; }
        }
#pragma unroll
        for (int e = 0; e < 16; ++e) Y[(row0 + i) * RW + h * HD + e * 8 + eg] = acc[e];
    }
}


__device__ __forceinline__ void p2_gmlp(const Params& p, LAS unsigned char* lds, int G, int bid) {
    const int tid = threadIdx.x, lane = tid & 63, w = tid >> 6, l15 = lane & 15, l4 = lane >> 4;
    const bf16_t* GU = (const bf16_t*)(p.ws + WS_Q + 4 * WS_SEG); const bf16_t* GV = (const bf16_t*)(p.ws + WS_Q + 5 * WS_SEG);
    const bf16_t* WSb = (const bf16_t*)(p.ws + WS_WS); bf16_t* MIX = (bf16_t*)(p.ws + WS_MIX);
    const float* lng = p.in[4]; const float* lnb = p.in[5]; const float* b_s = p.in[7];
    for (int blk = bid; blk < M / GB; blk += G) {
        const size_t rb = (size_t)blk * GB;
        __syncthreads();
        {
            u32x4 raw[16];
#pragma unroll
            for (int r = 0; r < 16; ++r) raw[r] = *(const u32x4*)(GV + (rb + 16 * w + r) * GW + 8 * lane);
            const f32x4 lg0 = ((const f32x4*)lng)[2 * lane], lg1 = ((const f32x4*)lng)[2 * lane + 1], lb0 = ((const f32x4*)lnb)[2 * lane], lb1 = ((const f32x4*)lnb)[2 * lane + 1];
            const float lg[8] = {lg0[0], lg0[1], lg0[2], lg0[3], lg1[0], lg1[1], lg1[2], lg1[3]}, lb[8] = {lb0[0], lb0[1], lb0[2], lb0[3], lb1[0], lb1[1], lb1[2], lb1[3]};
#pragma unroll
            for (int kb = 0; kb < 2; ++kb) {
                float v[8][8];
#pragma unroll
                for (int rr = 0; rr < 8; ++rr) {
                    const u32x4 x = raw[8 * kb + rr];
                    v[rr][0] = bflo(x.x); v[rr][1] = bfhi(x.x); v[rr][2] = bflo(x.y); v[rr][3] = bfhi(x.y); v[rr][4] = bflo(x.z); v[rr][5] = bfhi(x.z); v[rr][6] = bflo(x.w); v[rr][7] = bfhi(x.w);
                    float sm = 0.f;
#pragma unroll
                    for (int cc = 0; cc < 8; ++cc) sm += v[rr][cc];
                    const float mean = wave_sum(sm) * (1.0f / GW); float q = 0.f;
#pragma unroll
                    for (int cc = 0; cc < 8; ++cc) { v[rr][cc] -= mean; q += v[rr][cc] * v[rr][cc]; }
                    const float rstd = 1.0f / sqrtf(wave_sum(q) * (1.0f / GW) + EPS);
#pragma unroll
                    for (int cc = 0; cc < 8; ++cc) v[rr][cc] = v[rr][cc] * rstd * lg[cc] + lb[cc];
                }
                const int g = l4, kbg = 2 * w + kb;
#pragma unroll
                for (int cc = 0; cc < 8; ++cc) {
                    u32x4 o; o.x = cvt_pk_bf16(v[0][cc], v[1][cc]); o.y = cvt_pk_bf16(v[2][cc], v[3][cc]); o.z = cvt_pk_bf16(v[4][cc], v[5][cc]); o.w = cvt_pk_bf16(v[6][cc], v[7][cc]);
                    const int ph = 8 * l15 + (cc ^ (l15 & 7));
                    *(LAS u32x4*)(lds + (((g * 16 + kbg) * 128 + ph) << 4)) = o;
                }
            }
        }
        __syncthreads();
        {
            const int g = w >> 1, chh = w & 1;
            f32x4 acc[2][2][8];
#pragma unroll
            for (int a = 0; a < 2; ++a)
#pragma unroll
                for (int n = 0; n < 2; ++n)
#pragma unroll
                    for (int ti = 0; ti < 8; ++ti) acc[a][n][ti] = (f32x4){0.f, 0.f, 0.f, 0.f};
            const bf16_t* wp = WSb + ((size_t)(g * 128 + l15) * 128 + 8 * l4);
#pragma unroll 1
            for (int ks = 0; ks < 4; ++ks) {
                bf16x8 X[2][2];
#pragma unroll
                for (int a = 0; a < 2; ++a)
#pragma unroll
                    for (int n = 0; n < 2; ++n) { const int c = 64 * chh + 32 * a + 8 * (l15 >> 2) + 4 * n + (l15 & 3), ph = c ^ ((c >> 3) & 7);
                        X[a][n] = *(const LAS bf16x8*)(lds + (((g * 16 + 4 * ks + l4) * 128 + ph) << 4)); }
#pragma unroll
                for (int ti = 0; ti < 8; ++ti) {
                    if (ti < 4 && ks >= 2) continue;
                    const bf16x8 Y = *(const bf16x8*)(wp + (size_t)(16 * ti) * 128 + 32 * ks);
#pragma unroll
                    for (int a = 0; a < 2; ++a)
#pragma unroll
                        for (int n = 0; n < 2; ++n) acc[a][n][ti] = __builtin_amdgcn_mfma_f32_16x16x32_bf16(X[a][n], Y, acc[a][n][ti], 0, 0, 0);
                }
            }
#pragma unroll
            for (int ti = 0; ti < 8; ++ti) {
                const int t = 16 * ti + l15; const float bsv = b_s[g * 128 + t];
#pragma unroll
                for (int a = 0; a < 2; ++a) {
                    const int ch0 = g * 128 + 64 * chh + 32 * a + 8 * l4;
                    const u32x4 gu = *(const u32x4*)(GU + (rb + t) * GW + ch0);
                    f32x4 o0, o1;
                    o0[0] = bflo(gu.x) * (acc[a][0][ti][0] + bsv); o0[1] = bfhi(gu.x) * (acc[a][0][ti][1] + bsv); o0[2] = bflo(gu.y) * (acc[a][0][ti][2] + bsv); o0[3] = bfhi(gu.y) * (acc[a][0][ti][3] + bsv);
                    o1[0] = bflo(gu.z) * (acc[a][1][ti][0] + bsv); o1[1] = bfhi(gu.z) * (acc[a][1][ti][1] + bsv); o1[2] = bflo(gu.w) * (acc[a][1][ti][2] + bsv); o1[3] = bfhi(gu.w) * (acc[a][1][ti][3] + bsv);
                    store8(MIX + (rb + t) * DM + RW + ch0, o0, o1);
                }
            }
        }
    }
}


typedef float f32x16 __attribute__((ext_vector_type(16)));
typedef short s16x4 __attribute__((ext_vector_type(4)));
#define MFMA32(a, b, c) __builtin_amdgcn_mfma_f32_32x32x16_bf16((a), (b), (c), 0, 0, 0)
constexpr size_t WS_T = 368 * MiB;
__device__ __forceinline__ unsigned off_a(unsigned row, unsigned ch) { return 2048u * (row >> 3) + 512u * (ch >> 2) + 64u * (row & 7u) + 16u * ((ch & 3u) ^ ((row >> 2) & 3u)); }
__device__ __forceinline__ int crow(int reg, int h) { return (reg & 3) + 8 * (reg >> 2) + 4 * h; }
template <int S> __device__ __forceinline__ bf16x8 pack8(const f32x16& x) {
    u32x4 p; p.x = cvt_pk_bf16(x[8 * S], x[8 * S + 1]); p.y = cvt_pk_bf16(x[8 * S + 2], x[8 * S + 3]); p.z = cvt_pk_bf16(x[8 * S + 4], x[8 * S + 5]); p.w = cvt_pk_bf16(x[8 * S + 6], x[8 * S + 7]);
    return __builtin_bit_cast(bf16x8, p);
}
__device__ __forceinline__ unsigned tr_lane_base(int lane, int t) {
    const unsigned h = lane >> 5, blk = (lane >> 4) & 1, q = (lane & 15) >> 2, p = lane & 3;
    return off_a(8u * t + 4u * h + q, 2u * blk + (p >> 1)) + 8u * (p & 1);
}
template <int COFF> __device__ __forceinline__ void tr_frags64(bf16x8 (&f)[4], unsigned b0, unsigned b1) {
    s16x4 x0, x1, x2, x3, x4, x5, x6, x7;
    asm volatile("ds_read_b64_tr_b16 %0, %8 offset:%10\n\tds_read_b64_tr_b16 %1, %9 offset:%10\n\tds_read_b64_tr_b16 %2, %8 offset:%11\n\tds_read_b64_tr_b16 %3, %9 offset:%11\n\t"
                 "ds_read_b64_tr_b16 %4, %8 offset:%12\n\tds_read_b64_tr_b16 %5, %9 offset:%12\n\tds_read_b64_tr_b16 %6, %8 offset:%13\n\tds_read_b64_tr_b16 %7, %9 offset:%13\n\ts_waitcnt lgkmcnt(0)"
                 : "=&v"(x0), "=&v"(x1), "=&v"(x2), "=&v"(x3), "=&v"(x4), "=&v"(x5), "=&v"(x6), "=&v"(x7)
                 : "v"(b0), "v"(b1), "i"(COFF), "i"(COFF + 4096), "i"(COFF + 8192), "i"(COFF + 12288) : "memory");
    f[0] = __builtin_shufflevector(x0, x1, 0, 1, 2, 3, 4, 5, 6, 7); f[1] = __builtin_shufflevector(x2, x3, 0, 1, 2, 3, 4, 5, 6, 7);
    f[2] = __builtin_shufflevector(x4, x5, 0, 1, 2, 3, 4, 5, 6, 7); f[3] = __builtin_shufflevector(x6, x7, 0, 1, 2, 3, 4, 5, 6, 7);
}

__device__ __forceinline__ void p2_tseg(const Params& p, LAS unsigned char* lds, int G, int bid) {
    const int tid = threadIdx.x, lane = tid & 63, w = tid >> 6, et = w & 3, dp = w >> 2;
    const bf16_t* Kb = (const bf16_t*)(p.ws + WS_Q + WS_SEG); const bf16_t* Vb = (const bf16_t*)(p.ws + WS_Q + 2 * WS_SEG);
    float* Tb = (float*)(p.ws + WS_T);
    const unsigned lbase = (unsigned)(size_t)lds;
    const unsigned tb0 = tr_lane_base(lane, 0), tb1 = tr_lane_base(lane, 1);
    for (int item = bid; item < BATCH * NH * 8; item += G) {
        const int seg = item & 7, bh = item >> 3, h = bh & 3, b = bh >> 2;
        const float cd = exp2f(64.0f * log2f(1.0f - exp2f(-5.0f - (float)h)));
        const size_t row0 = (size_t)b * SEQ + seg * 512;
        f32x16 T0, T1;
#pragma unroll
        for (int i = 0; i < 16; ++i) { T0[i] = 0.f; T1[i] = 0.f; }
        u32x4 stg[8];
#define TS_LOAD(st) do { _Pragma("unroll") for (int u = 0; u < 4; ++u) { const int c = tid + 512 * u, rr = c >> 4, ch = c & 15; const size_t go = (row0 + 128 * (st) + rr) * RW + h * HD + ch * 8; \
            stg[u] = *(const u32x4*)(Kb + go); stg[4 + u] = *(const u32x4*)(Vb + go); } } while (0)
#define TS_WRITE(buf) do { _Pragma("unroll") for (int u = 0; u < 4; ++u) { const int c = tid + 512 * u, rr = c >> 4, ch = c & 15; const unsigned o = (buf) * 65536u + (rr >> 6) * 16384u + off_a(rr & 63, ch); \
            *(LAS u32x4*)(lds + o) = stg[u]; *(LAS u32x4*)(lds + 32768u + o) = stg[4 + u]; } } while (0)
        __syncthreads();
        TS_LOAD(0); TS_WRITE(0);
#pragma unroll 1
        for (int st = 0; st < 4; ++st) {
            __syncthreads();
            if (st < 3) TS_LOAD(st + 1);
            const unsigned kb = lbase + (st & 1) * 65536u, vb = kb + 32768u + 512u * et;
#pragma unroll
            for (int cc = 0; cc < 2; ++cc) {
                bf16x8 vf[4], kf[4];
                tr_frags64<0>(vf, vb + cc * 16384u + tb0, vb + cc * 16384u + tb1);
                T0 = T0 * cd; T1 = T1 * cd;
                const unsigned k0 = kb + cc * 16384u + 1024u * dp;
                tr_frags64<0>(kf, k0 + tb0, k0 + tb1);
#pragma unroll
                for (int f = 0; f < 4; ++f) T0 = MFMA32(kf[f], vf[f], T0);
                tr_frags64<512>(kf, k0 + tb0, k0 + tb1);
#pragma unroll
                for (int f = 0; f < 4; ++f) T1 = MFMA32(kf[f], vf[f], T1);
            }
            if (st < 3) TS_WRITE((st + 1) & 1);
        }
#undef TS_LOAD
#undef TS_WRITE
        f32x4* o0 = (f32x4*)(Tb + ((size_t)(item * 16 + (2 * dp) * 4 + et) * 64 + lane) * 16);
        f32x4* o1 = (f32x4*)(Tb + ((size_t)(item * 16 + (2 * dp + 1) * 4 + et) * 64 + lane) * 16);
#pragma unroll
        for (int i = 0; i < 4; ++i) { o0[i] = (f32x4){T0[4 * i], T0[4 * i + 1], T0[4 * i + 2], T0[4 * i + 3]}; o1[i] = (f32x4){T1[4 * i], T1[4 * i + 1], T1[4 * i + 2], T1[4 * i + 3]}; }
    }
}

__device__ __forceinline__ void p3_retention(const Params& p, LAS unsigned char* lds, int G, int bid) {
    const int tid = threadIdx.x, lane = tid & 63, w = tid >> 6, et = w & 3, it = w >> 2, r = lane & 31, hh = lane >> 5;
    const bf16_t* Qg = (const bf16_t*)(p.ws + WS_Q); const bf16_t* Kg = (const bf16_t*)(p.ws + WS_Q + WS_SEG); const bf16_t* Vg = (const bf16_t*)(p.ws + WS_Q + 2 * WS_SEG);
    const bf16_t* SG = (const bf16_t*)(p.ws + WS_Q + 3 * WS_SEG); bf16_t* MIX = (bf16_t*)(p.ws + WS_MIX);
    const float* Tb = (const float*)(p.ws + WS_T); const float* gn = p.in[3];
    const unsigned lbase = (unsigned)(size_t)lds;
    constexpr unsigned OT_OFF = 98304u, OT_LD = 132u;
    const unsigned tb0 = tr_lane_base(lane, 0), tb1 = tr_lane_base(lane, 1);
    const unsigned rr0 = off_a(r, hh), rr1 = off_a(r, 2 + hh);
    const int ri = tid >> 3, part = tid & 7;
    for (int item = bid; item < BATCH * NH * 8; item += G) {
        const int seg = item & 7, bh = item >> 3, h = bh & 3, b = bh >> 2;
        const float l2g = log2f(1.0f - exp2f(-5.0f - (float)h)), cd = exp2f(64.0f * l2g);
        const size_t row0 = (size_t)b * SEQ + seg * 512;
        f32x16 St[4];
#pragma unroll
        for (int dt = 0; dt < 4; ++dt)
#pragma unroll
            for (int i = 0; i < 16; ++i) St[dt][i] = 0.f;
#pragma unroll 1
        for (int sp = 0; sp < seg; ++sp) {
            const float wgt = exp2f(512.0f * l2g * (float)(seg - 1 - sp));
#pragma unroll
            for (int dt = 0; dt < 4; ++dt) {
                const f32x4* tp = (const f32x4*)(Tb + ((size_t)((bh * 8 + sp) * 16 + dt * 4 + et) * 64 + lane) * 16);
#pragma unroll
                for (int i = 0; i < 4; ++i) { const f32x4 t = tp[i]; St[dt][4 * i] += wgt * t[0]; St[dt][4 * i + 1] += wgt * t[1]; St[dt][4 * i + 2] += wgt * t[2]; St[dt][4 * i + 3] += wgt * t[3]; }
            }
        }
        u32x4 stg[6], sgr[2];
#define RT_LOAD(c) do { _Pragma("unroll") for (int u = 0; u < 2; ++u) { const int cq = tid + 512 * u, rr = cq >> 4, ch = cq & 15; const size_t go = (row0 + 64 * (c) + rr) * RW + h * HD + ch * 8; \
            stg[u] = *(const u32x4*)(Qg + go); stg[2 + u] = *(const u32x4*)(Kg + go); stg[4 + u] = *(const u32x4*)(Vg + go); } } while (0)
#define RT_WRITE(buf) do { _Pragma("unroll") for (int u = 0; u < 2; ++u) { const int cq = tid + 512 * u, rr = cq >> 4, ch = cq & 15; const unsigned o = (buf) * 49152u + off_a(rr, ch); \
            *(LAS u32x4*)(lds + o) = stg[u]; *(LAS u32x4*)(lds + 16384u + o) = stg[2 + u]; *(LAS u32x4*)(lds + 32768u + o) = stg[4 + u]; } } while (0)
        __syncthreads();
        RT_LOAD(0); RT_WRITE(0);
#pragma unroll 1
        for (int c = 0; c < 8; ++c) {
            __syncthreads();
            if (c < 7) RT_LOAD(c + 1);
            { const size_t so = (row0 + 64 * c + ri) * RW + h * HD + 16 * part; sgr[0] = *(const u32x4*)(SG + so); sgr[1] = *(const u32x4*)(SG + so + 8); }
            const LAS unsigned char* Qb = lds + (c & 1) * 49152u + 8192u * it;
            const LAS unsigned char* Kb = lds + (c & 1) * 49152u + 16384u;
            const unsigned kbu = lbase + (c & 1) * 49152u + 16384u, vbu = kbu + 16384u + 512u * et;
            f32x16 X0, X1, O;
#pragma unroll
            for (int i = 0; i < 16; ++i) { X0[i] = 0.f; X1[i] = 0.f; O[i] = 0.f; }
#pragma unroll
            for (int ks = 0; ks < 8; ++ks) {
                const unsigned ro = ((ks & 1) ? rr1 : rr0) + 512u * (ks >> 1);
                const bf16x8 bq = *(const LAS bf16x8*)(Qb + ro);
                const bf16x8 a0 = *(const LAS bf16x8*)(Kb + ro), a1 = *(const LAS bf16x8*)(Kb + 8192u + ro);
                X0 = MFMA32(a0, bq, X0); X1 = MFMA32(a1, bq, X1);
                if (ks & 1) __builtin_amdgcn_sched_barrier(0);
            }
            { float ebase = __builtin_amdgcn_exp2f(2.0f * l2g * (float)(4 * hh - (32 * it + r)));
              asm volatile("" : "+v"(ebase));
              const float g2 = __builtin_amdgcn_exp2f(2.0f * l2g), g2_8 = __builtin_amdgcn_exp2f(16.0f * l2g), g2_32 = __builtin_amdgcn_exp2f(64.0f * l2g), cinv = __builtin_amdgcn_exp2f(-64.0f * l2g);
              float e0 = ebase, e1 = ebase * g2_32;
#pragma unroll
              for (int qd = 0; qd < 4; ++qd) {
                  float a = e0, bq2 = e1;
#pragma unroll
                  for (int k = 0; k < 4; ++k) { X0[4 * qd + k] *= cinv * fminf(1.0f, a); X1[4 * qd + k] *= cinv * fminf(1.0f, bq2); a *= g2; bq2 *= g2; }
                  e0 *= g2_8; e1 *= g2_8;
              } }
            const bf16x8 P00 = pack8<0>(X0), P01 = pack8<1>(X0), P10 = pack8<0>(X1), P11 = pack8<1>(X1);
            __builtin_amdgcn_sched_barrier(0);
            bf16x8 vf[4];
            tr_frags64<0>(vf, vbu + tb0, vbu + tb1);
            O = MFMA32(vf[0], P00, O); O = MFMA32(vf[1], P01, O); O = MFMA32(vf[2], P10, O); O = MFMA32(vf[3], P11, O);
            __builtin_amdgcn_sched_barrier(0);
#pragma unroll
            for (int dt = 0; dt < 4; ++dt) {
                const s16x4 l0 = *(const LAS s16x4*)(Qb + off_a(r, 4 * dt + 0) + 8 * hh), h0 = *(const LAS s16x4*)(Qb + off_a(r, 4 * dt + 1) + 8 * hh);
                const s16x4 l1 = *(const LAS s16x4*)(Qb + off_a(r, 4 * dt + 2) + 8 * hh), h1 = *(const LAS s16x4*)(Qb + off_a(r, 4 * dt + 3) + 8 * hh);
                const bf16x8 q0 = __builtin_shufflevector(l0, h0, 0, 1, 2, 3, 4, 5, 6, 7), q1 = __builtin_shufflevector(l1, h1, 0, 1, 2, 3, 4, 5, 6, 7);
                O = MFMA32(pack8<0>(St[dt]), q0, O); O = MFMA32(pack8<1>(St[dt]), q1, O);
                if (dt & 1) __builtin_amdgcn_sched_barrier(0);
            }
            {
                bf16x8 kf[4];
                tr_frags64<0>(kf, kbu + tb0, kbu + tb1);
                St[0] = St[0] * cd;
#pragma unroll
                for (int f = 0; f < 4; ++f) St[0] = MFMA32(kf[f], vf[f], St[0]);
                tr_frags64<512>(kf, kbu + tb0, kbu + tb1);
                St[1] = St[1] * cd;
#pragma unroll
                for (int f = 0; f < 4; ++f) St[1] = MFMA32(kf[f], vf[f], St[1]);
                tr_frags64<1024>(kf, kbu + tb0, kbu + tb1);
                St[2] = St[2] * cd;
#pragma unroll
                for (int f = 0; f < 4; ++f) St[2] = MFMA32(kf[f], vf[f], St[2]);
                tr_frags64<1536>(kf, kbu + tb0, kbu + tb1);
                St[3] = St[3] * cd;
#pragma unroll
                for (int f = 0; f < 4; ++f) St[3] = MFMA32(kf[f], vf[f], St[3]);
            }
            __builtin_amdgcn_sched_barrier(0);
            { LAS float* ot = (LAS float*)(lds + OT_OFF) + (32 * it + r) * OT_LD + 32 * et + 4 * hh;
#pragma unroll
              for (int qd = 0; qd < 4; ++qd) *(LAS f32x4*)(ot + 8 * qd) = (f32x4){O[4 * qd], O[4 * qd + 1], O[4 * qd + 2], O[4 * qd + 3]}; }
            __syncthreads();
            { const LAS f32x4* op = (const LAS f32x4*)((const LAS float*)(lds + OT_OFF) + ri * OT_LD + 16 * part);
              f32x4 o[4]; float sm = 0.f;
#pragma unroll
              for (int u = 0; u < 4; ++u) { o[u] = op[u]; sm += (o[u][0] + o[u][1]) + (o[u][2] + o[u][3]); }
              sm += __shfl_xor(sm, 1); sm += __shfl_xor(sm, 2); sm += __shfl_xor(sm, 4);
              const float mean = sm * (1.0f / HD); float q = 0.f;
#pragma unroll
              for (int u = 0; u < 4; ++u) { o[u] = o[u] - mean; q += (o[u][0] * o[u][0] + o[u][1] * o[u][1]) + (o[u][2] * o[u][2] + o[u][3] * o[u][3]); }
              q += __shfl_xor(q, 1); q += __shfl_xor(q, 2); q += __shfl_xor(q, 4);
              const float rstd = 1.0f / sqrtf(q * (1.0f / HD) + EPS);
              const f32x4* gp = (const f32x4*)(gn + h * HD + 16 * part);
              const unsigned sw[8] = {sgr[0].x, sgr[0].y, sgr[0].z, sgr[0].w, sgr[1].x, sgr[1].y, sgr[1].z, sgr[1].w};
#pragma unroll
              for (int u = 0; u < 4; ++u) { const f32x4 g4 = gp[u];
                  o[u][0] = o[u][0] * rstd * g4[0] * bflo(sw[2 * u]); o[u][1] = o[u][1] * rstd * g4[1] * bfhi(sw[2 * u]);
                  o[u][2] = o[u][2] * rstd * g4[2] * bflo(sw[2 * u + 1]); o[u][3] = o[u][3] * rstd * g4[3] * bfhi(sw[2 * u + 1]); }
              bf16_t* mp = MIX + (row0 + 64 * c + ri) * DM + h * HD + 16 * part;
              store8(mp, o[0], o[1]); store8(mp + 8, o[2], o[3]); }
            if (c < 7) RT_WRITE((c + 1) & 1);
        }
#undef RT_LOAD
#undef RT_WRITE
    }
}

__device__ __forceinline__ void p3_gn_gate(const Params& p, int G, int bid) {
    const int tid = threadIdx.x, lane = tid & 63, wave = tid >> 6, gw = bid * 8 + wave, NGW = G * 8;
    const float* Y = (const float*)(p.ws + WS_Y); const bf16_t* SG = (const bf16_t*)(p.ws + WS_Q + 3 * WS_SEG); bf16_t* MIX = (bf16_t*)(p.ws + WS_MIX);
    const float* gn = p.in[3];
    const f32x4 g0 = ((const f32x4*)gn)[2 * lane], g1 = ((const f32x4*)gn)[2 * lane + 1];
    for (int m = gw; m < M; m += NGW) {
        const f32x4 a = ((const f32x4*)(Y + (size_t)m * RW))[2 * lane], b = ((const f32x4*)(Y + (size_t)m * RW))[2 * lane + 1];
        float s = (a[0] + a[1]) + (a[2] + a[3]) + (b[0] + b[1]) + (b[2] + b[3]);
        s += __shfl_xor(s, 1); s += __shfl_xor(s, 2); s += __shfl_xor(s, 4); s += __shfl_xor(s, 8);
        const float mean = s * (1.0f / HD);
        const f32x4 da = a - mean, db = b - mean;
        float q = (da[0] * da[0] + da[1] * da[1]) + (da[2] * da[2] + da[3] * da[3]) + (db[0] * db[0] + db[1] * db[1]) + (db[2] * db[2] + db[3] * db[3]);
        q += __shfl_xor(q, 1); q += __shfl_xor(q, 2); q += __shfl_xor(q, 4); q += __shfl_xor(q, 8);
        const float rstd = 1.0f / sqrtf(q * (1.0f / HD) + EPS);
        const u32x4 sg = ((const u32x4*)(SG + (size_t)m * RW))[lane];
        f32x4 o0, o1;
        o0[0] = da[0] * rstd * g0[0] * bflo(sg.x); o0[1] = da[1] * rstd * g0[1] * bfhi(sg.x); o0[2] = da[2] * rstd * g0[2] * bflo(sg.y); o0[3] = da[3] * rstd * g0[3] * bfhi(sg.y);
        o1[0] = db[0] * rstd * g1[0] * bflo(sg.z); o1[1] = db[1] * rstd * g1[1] * bfhi(sg.z); o1[2] = db[2] * rstd * g1[2] * bflo(sg.w); o1[3] = db[3] * rstd * g1[3] * bfhi(sg.w);
        store8(MIX + (size_t)m * DM + 8 * lane, o0, o1);
    }
}
__device__ __forceinline__ void p3_gmlp_naive(const Params& p, LAS unsigned char* lds, int G, int bid) {
    const int tid = threadIdx.x;
    const bf16_t* GU = (const bf16_t*)(p.ws + WS_Q + 4 * WS_SEG); const bf16_t* GV = (const bf16_t*)(p.ws + WS_Q + 5 * WS_SEG);
    const f32x2* st = (const f32x2*)(p.ws + WS_GST); bf16_t* MIX = (bf16_t*)(p.ws + WS_MIX);
    const float* lng = p.in[4]; const float* lnb = p.in[5]; const float* w_s = p.in[6]; const float* b_s = p.in[7];
    LAS float* vn = (LAS float*)lds; LAS float* wl = vn + 128 * 128;
    const int c = tid & 127, tg = tid >> 7;
    for (int item = bid; item < (M / GB) * NG; item += G) {
        const int g = item & 3, blk = item >> 2; const size_t rb = (size_t)blk * GB; const int ch = g * 128 + c;
        __syncthreads();
        const float lg = lng[ch], lb = lnb[ch];
        for (int s = tg; s < 128; s += 4) { const f32x2 ms = st[rb + s]; vn[s * 128 + c] = (bf2f(GV[(rb + s) * GW + ch]) - ms[0]) * ms[1] * lg + lb; }
        for (int idx = tid; idx < 128 * 128; idx += 512) wl[idx] = w_s[(size_t)g * 128 * 128 + idx];
        __syncthreads();
        for (int tt = 0; tt < 32; ++tt) { const int t = tg * 32 + tt; const int smax = (t < 64) ? 64 : 128; float sum = 0.f;
            for (int s = 0; s < smax; ++s) sum += wl[t * 128 + s] * vn[s * 128 + c];
            const float mixed = sum + b_s[g * 128 + t];
            const float o = bf2f(GU[(rb + t) * GW + ch]) * mixed;
            MIX[(rb + t) * DM + RW + ch] = (bf16_t)(cvt_pk_bf16(o, 0.f) & 0xffffu); }
    }
}

__device__ __forceinline__ void p7_final(const Params& p, int G, int bid) {
    const int tid = threadIdx.x, lane = tid & 63, wave = tid >> 6, gw = bid * 8 + wave, NGW = G * 8;
    const float* ss = (const float*)(p.ws + WS_SS2); const float* fg = p.in[13];
    f32x4 gv[4];
#pragma unroll
    for (int j = 0; j < 4; ++j) gv[j] = ((const f32x4*)fg)[lane + 64 * j];
    for (int m = gw; m < M; m += NGW) {
        const float rs = row_rstd(ss, m);
        f32x4* xr = (f32x4*)(p.out + (size_t)m * DM) + lane;
#pragma unroll
        for (int j = 0; j < 4; ++j) { f32x4 v = xr[64 * j]; v = v * rs * gv[j]; xr[64 * j] = v; }
    }
}

__global__ void __launch_bounds__(512, 2) fwd_kernel(Params p) {
    extern __shared__ __attribute__((aligned(16))) unsigned char lds_raw[];
    LAS unsigned char* lds = (LAS unsigned char*)lds_raw;
    const int G = gridDim.x, bid = blockIdx.x;
    unsigned char* ws = p.ws;
    const int lo = p.ph_lo, hi = p.ph_hi;
#define IN(k) (lo <= (k) && (k) < hi)
#define SEAM(k) do { if (IN(k) && IN((k) + 1)) cg::this_grid().sync(); } while (0)
    if (IN(0)) { p0_prologue(p, lds, G, bid); }
    SEAM(0);
    if (IN(1)) { EpiProj E{(bf16_t*)(ws + WS_Q), (const f32x2*)(ws + WS_ROPE)};
                 Gemm g{(const bf16_t*)(ws + WS_XN), (const bf16_t*)(ws + WS_W1), M, NPROJ, DM}; StaticOrder S; S.init(M, NPROJ, G, bid); gemm_phase<EpiProj, StaticOrder, true, true>(lds, g, S, E); }
    SEAM(1);
    if (IN(2)) { p2_tseg(p, lds, G, bid); p2_gmlp(p, lds, G, bid); }
    SEAM(2);
    if (IN(3)) { p3_retention(p, lds, G, bid); }
    SEAM(3);
    if (IN(4)) { EpiResid E{p.in[0], p.out, (bf16_t*)(ws + WS_XN), (float*)(ws + WS_SS1)};
                 Gemm g{(const bf16_t*)(ws + WS_MIX), (const bf16_t*)(ws + WS_W4), M, DM, DM}; StaticOrder S; S.init(M, DM, G, bid); gemm_phase<EpiResid, StaticOrder, true, true>(lds, g, S, E); }
    SEAM(4);
    if (IN(5)) { EpiSwiglu E{(bf16_t*)(ws + WS_HID), (const float*)(ws + WS_SS1)};
                 Gemm g{(const bf16_t*)(ws + WS_XN), (const bf16_t*)(ws + WS_W5), M, NFF2, DM}; StaticOrder S; S.init(M, NFF2, G, bid); gemm_phase<EpiSwiglu, StaticOrder, true, true>(lds, g, S, E); }
    SEAM(5);
    if (IN(6)) { EpiResid E{p.out, p.out, nullptr, (float*)(ws + WS_SS2)};
                 Gemm g{(const bf16_t*)(ws + WS_HID), (const bf16_t*)(ws + WS_W6), M, DM, DFF}; StaticOrder S; S.init(M, DM, G, bid); gemm_phase<EpiResid, StaticOrder, true, true>(lds, g, S, E); }
    SEAM(6);
    if (IN(7)) { p7_final(p, G, bid); }
#undef IN
#undef SEAM
}

extern "C" void kernel_launch(void* const* d_in, const int* in_sizes, int n_in, void* d_out, int out_size, void* d_ws, size_t ws_size, hipStream_t stream) {
    static int grid = 0;
    if (grid == 0) {
        if (n_in != 14 || in_sizes[0] != M * DM || out_size != M * DM || ws_size < WS_END) { fprintf(stderr, "kernel_launch: unexpected shapes (n_in %d, in0 %d, out %d, ws %zu)\n", n_in, n_in > 0 ? in_sizes[0] : -1, out_size, ws_size); grid = -1; return; }
        int dev = 0, cus = 0, per_cu = 0;
        (void)hipGetDevice(&dev); (void)hipDeviceGetAttribute(&cus, hipDeviceAttributeMultiprocessorCount, dev);
        (void)hipFuncSetAttribute((const void*)fwd_kernel, hipFuncAttributeMaxDynamicSharedMemorySize, LDS_BYTES);
        (void)hipOccupancyMaxActiveBlocksPerMultiprocessor(&per_cu, (const void*)fwd_kernel, 512, LDS_BYTES);
        if (per_cu < 1) { fprintf(stderr, "kernel_launch: occupancy query says %d blocks per CU\n", per_cu); per_cu = 1; }
        if (per_cu > 1) per_cu = 1;
        grid = cus * per_cu;
        (void)hipGetLastError();
    }
    if (grid < 0) return;
    Params p{};
    for (int i = 0; i < 14; ++i) p.in[i] = (const float*)d_in[i];
    p.out = (float*)d_out; p.ws = (unsigned char*)d_ws;
    const int per = NPHASE / N_LAUNCHES;
    for (int li = 0; li < N_LAUNCHES; ++li) {
        p.ph_lo = li * per; p.ph_hi = (li == N_LAUNCHES - 1) ? NPHASE : (li + 1) * per;
        void* args[] = {&p};
        hipError_t e = hipLaunchCooperativeKernel((const void*)fwd_kernel, dim3(grid), dim3(512), args, LDS_BYTES, stream);
        if (e != hipSuccess) { fprintf(stderr, "kernel_launch: cooperative launch %d failed: %s (grid %d)\n", li, hipGetErrorString(e), grid); break; }
    }
}
```

```cpp
#include <hip/hip_runtime.h>
#include <hip/hip_cooperative_groups.h>
#include <cstdio>
#include <cstdint>
namespace cg = cooperative_groups;

#ifndef N_LAUNCHES
#define N_LAUNCHES 1
#endif

#define LAS __attribute__((address_space(3)))
typedef unsigned short bf16_t;
typedef short bf16x8 __attribute__((ext_vector_type(8)));
typedef float f32x4 __attribute__((ext_vector_type(4)));
typedef float f32x2 __attribute__((ext_vector_type(2)));
typedef unsigned u32x4 __attribute__((ext_vector_type(4)));
typedef unsigned u32x2 __attribute__((ext_vector_type(2)));

constexpr int BATCH = 8, SEQ = 4096, DM = 1024, M = BATCH * SEQ;
constexpr int RW = 512, HD = 128, NH = 4, GW = 512, GB = 128, NG = 4, CHUNK = 64;
constexpr int NPROJ = 3072, DFF = 2816, NFF2 = 2 * DFF;
constexpr float EPS = 1e-6f;
constexpr int NPHASE = 8;

constexpr size_t MiB = 1u << 20;
constexpr size_t WS_W1 = 2 * MiB;
constexpr size_t WS_W4 = 8 * MiB;
constexpr size_t WS_W5 = 10 * MiB;
constexpr size_t WS_W6 = 22 * MiB;
constexpr size_t WS_WS = 28 * MiB;
constexpr size_t WS_SS1 = 29 * MiB;
constexpr size_t WS_SS2 = 31 * MiB;
constexpr size_t WS_ROPE = 33 * MiB;
constexpr size_t WS_GST = 35 * MiB;
constexpr size_t WS_XN = 48 * MiB;
constexpr size_t WS_Q = 112 * MiB;
constexpr size_t WS_SEG = 32 * MiB;
constexpr size_t WS_HID = 112 * MiB;
constexpr size_t WS_MIX = 304 * MiB;
constexpr size_t WS_Y = 368 * MiB;
constexpr size_t WS_END = 432 * MiB;

constexpr int LDS_BYTES = 147456;

typedef __bf16 bf16x2_t __attribute__((ext_vector_type(2)));
__device__ __forceinline__ unsigned cvt_pk_bf16(float lo, float hi) { bf16x2_t v = {(__bf16)lo, (__bf16)hi}; return __builtin_bit_cast(unsigned, v); }
__device__ __forceinline__ float bf2f(bf16_t b) { return __uint_as_float(((unsigned)b) << 16); }
__device__ __forceinline__ float bflo(unsigned w) { return __uint_as_float(w << 16); }
__device__ __forceinline__ float bfhi(unsigned w) { return __uint_as_float(w & 0xffff0000u); }
__device__ __forceinline__ float wave_sum(float v) {
#pragma unroll
    for (int o = 1; o < 64; o <<= 1) v += __shfl_xor(v, o);
    return v;
}
__device__ __forceinline__ float sigmoidf_(float x) { return __builtin_amdgcn_rcpf(1.0f + __builtin_amdgcn_exp2f(-1.4426950408889634f * x)); }
__device__ __forceinline__ float silu_(float x) { return x * sigmoidf_(x); }
__device__ __forceinline__ float gelu_(float x) { const float z = 1.5957691216057308f * (x + 0.044715f * x * x * x); return x * sigmoidf_(z); }

#define PG8_LAS LAS
constexpr int BM = 256, BK = 64, HALF = 128, HTB = HALF * BK * 2  , STAGE_BYTES = 8 * HTB, NXCD = 8, WGM = 8;

__host__ __device__ __forceinline__ int lds_byte(int r, int c) { const int st = (r >> 4) * 2 + (c >> 5), rr = r & 15, cc = c & 31, ob = rr * 64 + cc * 2; return st * 1024 + (ob ^ (((ob >> 9) & 1) << 5)); }
__host__ __device__ __forceinline__ void stage_rc(int b, int& R, int& C) { const int st = b / 1024, sb = b % 1024, swz = sb ^ (((sb >> 9) & 1) << 5); R = (st >> 1) * 16 + swz / 64; C = (st & 1) * 32 + (swz % 64) / 2; }
__host__ __device__ __forceinline__ int perm32(int rho) { const int n = rho >> 4, i = rho & 15; return 8 * (i >> 2) + 4 * n + (i & 3); }
struct Unit { int pm, pn; };
struct StaticOrder {
    int nM, nN, nwg, G, c;
    __host__ __device__ void init(int M_, int N_, int G_, int c_) { nM = M_ / BM; nN = N_ / BM; nwg = nM * nN; G = G_; c = c_; }
    __host__ __device__ bool next(int i, Unit& u) const {
        const long L = (long)i * G + c; if (L >= nwg) return false;
        int wgid = (int)L; { const int q = nwg / NXCD, r = nwg % NXCD, xcd = wgid % NXCD, off = wgid / NXCD; wgid = (xcd < r ? xcd * (q + 1) : r * (q + 1) + (xcd - r) * q) + off; }
        const int nig = WGM * nN, gid = wgid / nig, fm = gid * WGM, gsz = (nM - fm) < WGM ? (nM - fm) : WGM;
        u.pm = fm + ((wgid % nig) % gsz); u.pn = (wgid % nig) / gsz; return true;
    }
    __device__ __forceinline__ void a_ready(const Unit&) const {}
    __device__ __forceinline__ void done(const Unit&) const {}
};
struct Gemm { const bf16_t* A; const bf16_t* Bt; int M, N, K; };

typedef f32x4 Acc[2][2][4][2];

template <class Epi, class Sched, bool ALIGN_EPI = false, bool SP2 = false>
__device__ __forceinline__ void gemm_phase(PG8_LAS unsigned char* lds, const Gemm g, const Sched& S, const Epi& E) {
    const int tid = threadIdx.x, wid = __builtin_amdgcn_readfirstlane(tid >> 6), lane = tid & 63, wr = wid >> 2, wc = wid & 3, fr = lane & 15, fq = lane >> 4;
    const int K = g.K, nt = K / BK;
    unsigned voffA[2], voffB[2];
#pragma unroll
    for (int i = 0; i < 2; ++i) { int R, C; stage_rc(tid * 16 + i * 8192, R, C); const int Rb = Epi::PERM ? ((R & ~31) + perm32(R & 31)) : R;
        voffA[i] = (unsigned)(R * K + C) * 2u; voffB[i] = (unsigned)(Rb * K + C) * 2u; }
    const size_t kstep = (size_t)(BK * 2);
    const size_t hstep = (size_t)HALF * K * 2;
    const size_t tstep = 2 * hstep;
    const unsigned ldsw = (unsigned)wid * 1024u;
    const int aoff = lds_byte(wr * 64 + fr, fq * 8), boff = lds_byte(wc * 32 + fr, fq * 8);
#define PG8_SA(b, h) (((b) * 2 + (h)) * HTB)
#define PG8_SB(b, h) ((4 + (b) * 2 + (h)) * HTB)
#define PG8_STAGE(bufoff, gbase, voff) do { _Pragma("unroll") for (int _i = 0; _i < 2; ++_i) \
        __builtin_amdgcn_global_load_lds((const unsigned*)((const char*)(gbase) + (voff)[_i]), (PG8_LAS unsigned*)(lds + (bufoff) + ldsw + _i * 8192), 16, 0, 0); } while (0)
#define PG8_LDA(dst, b, h) do { _Pragma("unroll") for (int m = 0; m < 4; ++m) _Pragma("unroll") for (int k = 0; k < 2; ++k) dst[m][k] = *(const PG8_LAS bf16x8*)(lds + PG8_SA(b, h) + aoff + m * 2048 + k * 1024); } while (0)
#define PG8_LDB(dst, b, h) do { _Pragma("unroll") for (int n = 0; n < 2; ++n) _Pragma("unroll") for (int k = 0; k < 2; ++k) dst[n][k] = *(const PG8_LAS bf16x8*)(lds + PG8_SB(b, h) + boff + n * 2048 + k * 1024); } while (0)
#define PG8_MMA(ai, bj, At, Bt) do { __builtin_amdgcn_s_setprio(1); _Pragma("unroll") for (int m = 0; m < 4; ++m) _Pragma("unroll") for (int n = 0; n < 2; ++n) _Pragma("unroll") for (int k = 0; k < 2; ++k) \
        acc[ai][bj][m][n] = __builtin_amdgcn_mfma_f32_16x16x32_bf16(Bt[n][k], At[m][k], acc[ai][bj][m][n], 0, 0, 0); __builtin_amdgcn_s_setprio(0); } while (0)
#define PG8_WAIT_V(n) asm volatile("s_waitcnt vmcnt(" #n ")" ::: "memory")
#define PG8_WAIT_L(n) asm volatile("s_waitcnt lgkmcnt(" #n ")" ::: "memory")
#define PG8_BAR __builtin_amdgcn_s_barrier()
#define PG8_SCHED __builtin_amdgcn_sched_barrier(0)
    Unit cur, nxt; int ui = 0;
    if (!S.next(0, cur)) return;
    f32x4 acc[2][2][4][2];
#pragma unroll
    for (int a = 0; a < 2; ++a)
#pragma unroll
        for (int b = 0; b < 2; ++b)
#pragma unroll
            for (int m = 0; m < 4; ++m)
#pragma unroll
                for (int n = 0; n < 2; ++n) acc[a][b][m][n] = (f32x4){0.f, 0.f, 0.f, 0.f};
    bf16x8 At[4][2], B0[2][2], B1[2][2];
    const char* cA = (const char*)g.A + (size_t)cur.pm * tstep; const char* cB = (const char*)g.Bt + (size_t)cur.pn * tstep;
    S.a_ready(cur);
    if constexpr (SP2) {
        PG8_STAGE(PG8_SB(0, 0), cB, voffB); PG8_STAGE(PG8_SB(0, 1), cB + hstep, voffB); PG8_STAGE(PG8_SA(0, 0), cA, voffA); PG8_STAGE(PG8_SA(0, 1), cA + hstep, voffA);
        if (wr == 1) PG8_BAR;
        PG8_WAIT_V(2); PG8_BAR;
        PG8_STAGE(PG8_SB(1, 0), cB + kstep, voffB); PG8_STAGE(PG8_SA(1, 0), cA + kstep, voffA); PG8_STAGE(PG8_SB(1, 1), cB + hstep + kstep, voffB);
        PG8_WAIT_V(6); PG8_BAR;
    } else {
        PG8_STAGE(PG8_SB(0, 0), cB, voffB); PG8_STAGE(PG8_SA(0, 0), cA, voffA); PG8_STAGE(PG8_SB(0, 1), cB + hstep, voffB); PG8_STAGE(PG8_SA(0, 1), cA + hstep, voffA);
        if (wr == 1) PG8_BAR;
        PG8_WAIT_V(4); PG8_BAR;
        PG8_STAGE(PG8_SB(1, 0), cB + kstep, voffB); PG8_STAGE(PG8_SA(1, 0), cA + kstep, voffA); PG8_STAGE(PG8_SB(1, 1), cB + hstep + kstep, voffB);
        PG8_WAIT_V(6); PG8_BAR;
    }
    for (;;) {
        const bool has_next = S.next(ui + 1, nxt);
        const char* nA = has_next ? (const char*)g.A + (size_t)nxt.pm * tstep : cA; const char* nB = has_next ? (const char*)g.Bt + (size_t)nxt.pn * tstep : cB;
        for (int t = 0; t < nt; t += 2) {
            const bool last = (t == nt - 2);
            const char* a1 = cA + (size_t)(t + 1) * kstep;
            const char* a2 = last ? nA : cA + (size_t)(t + 2) * kstep; const char* b2 = last ? nB : cB + (size_t)(t + 2) * kstep;
            const char* a3 = a2 + kstep; const char* b3 = b2 + kstep;
            if (last && has_next) S.a_ready(nxt);
            if constexpr (SP2) {
            PG8_LDB(B0, 0, 0); PG8_LDB(B1, 0, 1); PG8_SCHED; PG8_LDA(At, 0, 0); PG8_STAGE(PG8_SA(1, 1), a1 + hstep, voffA);
            PG8_WAIT_V(8); PG8_WAIT_L(0); PG8_BAR; PG8_MMA(0, 0, At, B0); PG8_MMA(0, 1, At, B1); PG8_BAR; PG8_SCHED;
            PG8_LDA(At, 0, 1); PG8_STAGE(PG8_SB(0, 0), b2, voffB); PG8_STAGE(PG8_SB(0, 1), b2 + hstep, voffB); PG8_STAGE(PG8_SA(0, 0), a2, voffA);
            PG8_WAIT_V(8); PG8_WAIT_L(0); PG8_BAR; PG8_MMA(1, 0, At, B0); PG8_MMA(1, 1, At, B1); PG8_BAR; PG8_SCHED;
            PG8_LDB(B0, 1, 0); PG8_LDB(B1, 1, 1); PG8_SCHED; PG8_LDA(At, 1, 0); PG8_STAGE(PG8_SA(0, 1), a2 + hstep, voffA);
            PG8_WAIT_V(8); PG8_WAIT_L(0); PG8_BAR; PG8_MMA(0, 0, At, B0); PG8_MMA(0, 1, At, B1); PG8_BAR; PG8_SCHED;
            PG8_LDA(At, 1, 1); PG8_STAGE(PG8_SB(1, 0), b3, voffB); PG8_STAGE(PG8_SB(1, 1), b3 + hstep, voffB); PG8_STAGE(PG8_SA(1, 0), a3, voffA);
            PG8_WAIT_V(8); PG8_WAIT_L(0); PG8_BAR; PG8_MMA(1, 0, At, B0); PG8_MMA(1, 1, At, B1); PG8_BAR; PG8_SCHED;
            } else {
            PG8_LDB(B0, 0, 0); PG8_SCHED; PG8_LDA(At, 0, 0); PG8_STAGE(PG8_SA(1, 1), a1 + hstep, voffA);
            PG8_WAIT_L(8); PG8_BAR; PG8_WAIT_L(0); PG8_MMA(0, 0, At, B0); PG8_BAR; PG8_SCHED;
            PG8_LDB(B1, 0, 1); PG8_STAGE(PG8_SB(0, 0), b2, voffB);
            PG8_BAR; PG8_WAIT_L(0); PG8_MMA(0, 1, At, B1); PG8_BAR;
            PG8_LDA(At, 0, 1); PG8_STAGE(PG8_SA(0, 0), a2, voffA);
            PG8_BAR; PG8_WAIT_L(0); PG8_MMA(1, 0, At, B0); PG8_BAR; PG8_SCHED;
            PG8_STAGE(PG8_SB(0, 1), b2 + hstep, voffB);
            PG8_WAIT_V(6); PG8_BAR; PG8_MMA(1, 1, At, B1); PG8_BAR;
            PG8_LDB(B0, 1, 0); PG8_SCHED; PG8_LDA(At, 1, 0); PG8_STAGE(PG8_SA(0, 1), a2 + hstep, voffA);
            PG8_WAIT_L(8); PG8_BAR; PG8_WAIT_L(0); PG8_MMA(0, 0, At, B0); PG8_BAR; PG8_SCHED;
            PG8_LDB(B1, 1, 1); PG8_STAGE(PG8_SB(1, 0), b3, voffB);
            PG8_BAR; PG8_WAIT_L(0); PG8_MMA(0, 1, At, B1); PG8_BAR;
            PG8_LDA(At, 1, 1); PG8_STAGE(PG8_SA(1, 0), a3, voffA);
            PG8_BAR; PG8_WAIT_L(0); PG8_MMA(1, 0, At, B0); PG8_BAR; PG8_SCHED;
            PG8_STAGE(PG8_SB(1, 1), b3 + hstep, voffB);
            PG8_WAIT_V(6); PG8_BAR; PG8_MMA(1, 1, At, B1); PG8_BAR;
            }
        }
        if constexpr (ALIGN_EPI) { if (wr == 0) PG8_BAR; }
        if constexpr (!Epi::AFTER_DRAIN) { E(acc, cur, wr, wc, fr, fq); S.done(cur); }
        if (!has_next) break;
#pragma unroll
        for (int a = 0; a < 2; ++a)
#pragma unroll
            for (int b = 0; b < 2; ++b)
#pragma unroll
                for (int m = 0; m < 4; ++m)
#pragma unroll
                    for (int n = 0; n < 2; ++n) acc[a][b][m][n] = (f32x4){0.f, 0.f, 0.f, 0.f};
        cur = nxt; cA = nA; cB = nB; ++ui;
        if constexpr (ALIGN_EPI) { if (wr == 1) PG8_BAR; }
    }
    PG8_WAIT_V(0);
    if constexpr (!ALIGN_EPI) { if (wr == 0) PG8_BAR; }
    PG8_BAR;
    if constexpr (Epi::AFTER_DRAIN) { E.fused(acc, cur, wr, wc, fr, fq, lds, wid, lane); S.done(cur); }
#undef PG8_SA
#undef PG8_SB
#undef PG8_STAGE
#undef PG8_LDA
#undef PG8_LDB
#undef PG8_MMA
#undef PG8_WAIT_V
#undef PG8_WAIT_L
#undef PG8_BAR
#undef PG8_SCHED
}

__device__ __forceinline__ void store8(bf16_t* p, const f32x4& a, const f32x4& b) {
    u32x4 w; w.x = cvt_pk_bf16(a[0], a[1]); w.y = cvt_pk_bf16(a[2], a[3]); w.z = cvt_pk_bf16(b[0], b[1]); w.w = cvt_pk_bf16(b[2], b[3]);
    *(u32x4*)p = w;
}
struct EpiProj {
    static constexpr bool PERM = true, AFTER_DRAIN = false;
    bf16_t* qkv;
    const f32x2* rope;
    __device__ __forceinline__ void operator()(const Acc& acc, const Unit& u, int wr, int wc, int fr, int fq) const {
        const int kind = u.pn >> 1, halfsel = u.pn & 1;
        bf16_t* dst = qkv + (size_t)kind * (WS_SEG / 2);
        const int row0 = u.pm * BM + wr * 64 + fr;
        if (kind < 2) {
            const int hh = wc >> 1, i0 = 32 * (wc & 1) + 8 * fq;
            const float l2g = __builtin_log2f(1.0f - __builtin_exp2f(-5.0f - (float)(2 * halfsel + hh)));
            const int cbase = halfsel * 256 + hh * 128 + i0;
#pragma unroll
            for (int ai = 0; ai < 2; ++ai)
#pragma unroll
                for (int m = 0; m < 4; ++m) {
                    const int r = row0 + ai * HALF + m * 16, pos = r & (SEQ - 1), ic = pos & (CHUNK - 1);
                    const float sc = (kind == 0) ? __builtin_amdgcn_exp2f(l2g * (float)(ic + 1)) * 0.08838834764831845f : __builtin_amdgcn_exp2f(l2g * (float)(CHUNK - 1 - ic));
                    const f32x4* tp = (const f32x4*)(rope + (size_t)pos * 64 + i0);
                    const f32x4 t0 = tp[0], t1 = tp[1], t2 = tp[2], t3 = tp[3];
                    const f32x4 xa0 = acc[ai][0][m][0], xa1 = acc[ai][0][m][1], xb0 = acc[ai][1][m][0], xb1 = acc[ai][1][m][1];
                    f32x4 o10, o11, o20, o21;
                    o10[0] = (xa0[0] * t0[0] - xb0[0] * t0[1]) * sc; o20[0] = (xb0[0] * t0[0] + xa0[0] * t0[1]) * sc;
                    o10[1] = (xa0[1] * t0[2] - xb0[1] * t0[3]) * sc; o20[1] = (xb0[1] * t0[2] + xa0[1] * t0[3]) * sc;
                    o10[2] = (xa0[2] * t1[0] - xb0[2] * t1[1]) * sc; o20[2] = (xb0[2] * t1[0] + xa0[2] * t1[1]) * sc;
                    o10[3] = (xa0[3] * t1[2] - xb0[3] * t1[3]) * sc; o20[3] = (xb0[3] * t1[2] + xa0[3] * t1[3]) * sc;
                    o11[0] = (xa1[0] * t2[0] - xb1[0] * t2[1]) * sc; o21[0] = (xb1[0] * t2[0] + xa1[0] * t2[1]) * sc;
                    o11[1] = (xa1[1] * t2[2] - xb1[1] * t2[3]) * sc; o21[1] = (xb1[1] * t2[2] + xa1[1] * t2[3]) * sc;
                    o11[2] = (xa1[2] * t3[0] - xb1[2] * t3[1]) * sc; o21[2] = (xb1[2] * t3[0] + xa1[2] * t3[1]) * sc;
                    o11[3] = (xa1[3] * t3[2] - xb1[3] * t3[3]) * sc; o21[3] = (xb1[3] * t3[2] + xa1[3] * t3[3]) * sc;
                    bf16_t* rp = dst + (size_t)r * RW + cbase;
                    store8(rp, o10, o11); store8(rp + 64, o20, o21);
                }
        } else {
            const int cbase = halfsel * 256 + wc * 32 + 8 * fq;
#pragma unroll
            for (int ai = 0; ai < 2; ++ai)
#pragma unroll
                for (int m = 0; m < 4; ++m) {
                    bf16_t* rp = dst + (size_t)(row0 + ai * HALF + m * 16) * RW + cbase;
#pragma unroll
                    for (int bj = 0; bj < 2; ++bj) {
                        f32x4 v0 = acc[ai][bj][m][0], v1 = acc[ai][bj][m][1];
                        if (kind == 3) {
#pragma unroll
                            for (int j = 0; j < 4; ++j) { v0[j] = silu_(v0[j]); v1[j] = silu_(v1[j]); }
                        } else if (kind >= 4) {
#pragma unroll
                            for (int j = 0; j < 4; ++j) { v0[j] = gelu_(v0[j]); v1[j] = gelu_(v1[j]); }
                        }
                        store8(rp + bj * HALF, v0, v1);
                    }
                }
        }
    }
};
struct EpiResid {
    static constexpr bool PERM = true, AFTER_DRAIN = false;
    const float* base; float* out; bf16_t* outb; float* ss;
    __device__ __forceinline__ void operator()(const Acc& acc, const Unit& u, int wr, int wc, int fr, int fq) const {
        const int row0 = u.pm * BM + wr * 64 + fr, col0 = u.pn * BM + wc * 32 + 8 * fq;
#pragma unroll
        for (int ai = 0; ai < 2; ++ai)
#pragma unroll
            for (int m = 0; m < 4; ++m) {
                const int r = row0 + ai * HALF + m * 16; const size_t off = (size_t)r * DM + col0; float q = 0.f;
#pragma unroll
                for (int bj = 0; bj < 2; ++bj) {
                    const f32x4 b0 = *(const f32x4*)(base + off + bj * HALF), b1 = *(const f32x4*)(base + off + bj * HALF + 4);
                    const f32x4 v0 = acc[ai][bj][m][0] + b0, v1 = acc[ai][bj][m][1] + b1;
                    *(f32x4*)(out + off + bj * HALF) = v0; *(f32x4*)(out + off + bj * HALF + 4) = v1;
                    if (outb) store8(outb + off + bj * HALF, v0, v1);
                    q += (v0[0] * v0[0] + v0[1] * v0[1]) + (v0[2] * v0[2] + v0[3] * v0[3]) + (v1[0] * v1[0] + v1[1] * v1[1]) + (v1[2] * v1[2] + v1[3] * v1[3]);
                }
                q += __shfl_xor(q, 16); q += __shfl_xor(q, 32);
                if (fq == 0) ss[(size_t)(u.pn * 4 + wc) * M + r] = q;
            }
    }
};
__device__ __forceinline__ float row_rstd(const float* ss, int r) {
    float s = 0.f;
#pragma unroll
    for (int t = 0; t < 16; ++t) s += ss[(size_t)t * M + r];
    return 1.0f / sqrtf(s * (1.0f / DM) + EPS);
}
struct EpiSwiglu {
    static constexpr bool PERM = true, AFTER_DRAIN = false;
    bf16_t* hid; const float* ss;
    __device__ __forceinline__ void operator()(const Acc& acc, const Unit& u, int wr, int wc, int fr, int fq) const {
        const int row0 = u.pm * BM + wr * 64 + fr, col0 = u.pn * HALF + wc * 32 + 8 * fq;
#pragma unroll
        for (int ai = 0; ai < 2; ++ai)
#pragma unroll
            for (int m = 0; m < 4; ++m) {
                const int r = row0 + ai * HALF + m * 16; const float rs = row_rstd(ss, r);
                f32x4 h0, h1;
#pragma unroll
                for (int j = 0; j < 4; ++j) { h0[j] = silu_(acc[ai][0][m][0][j] * rs) * (acc[ai][1][m][0][j] * rs); h1[j] = silu_(acc[ai][0][m][1][j] * rs) * (acc[ai][1][m][1][j] * rs); }
                store8(hid + (size_t)r * DFF + col0, h0, h1);
            }
    }
};

__device__ __forceinline__ void transpose_item(const float* __restrict__ W, int ldw, int srccol0, int k0, const float* __restrict__ kscale, bf16_t* __restrict__ WT, int K, int dstrow0, LAS float* scr, int lane) {
#pragma unroll 8
    for (int i = 0; i < 32; ++i) { const int kk = 2 * i + (lane >> 5); float v = W[(size_t)(k0 + kk) * ldw + srccol0 + (lane & 31)]; if (kscale) v *= kscale[k0 + kk]; scr[kk * 33 + (lane & 31)] = v; }
    asm volatile("s_waitcnt lgkmcnt(0)" ::: "memory");
    const int c = lane & 7;
#pragma unroll
    for (int j = 0; j < 4; ++j) { const int n = (lane >> 3) + 8 * j; const LAS float* s = scr + (8 * c) * 33 + n;
        u32x4 o; o.x = cvt_pk_bf16(s[0 * 33], s[1 * 33]); o.y = cvt_pk_bf16(s[2 * 33], s[3 * 33]); o.z = cvt_pk_bf16(s[4 * 33], s[5 * 33]); o.w = cvt_pk_bf16(s[6 * 33], s[7 * 33]);
        *(u32x4*)(WT + (size_t)(dstrow0 + n) * K + k0 + 8 * c) = o; }
    asm volatile("s_waitcnt lgkmcnt(0)" ::: "memory");
}
__device__ __forceinline__ void sincos_d(double ang, float& s, float& c) {
    const double k = rint(ang * 0.63661977236758134308);
    const double r = fma(-k, 1.57079632679489661923, ang);
    const int q = (int)(((long long)k) & 3);
    const float x = (float)r, x2 = x * x;
    const float sp = x * (1.0f + x2 * (-1.6666667e-1f + x2 * (8.3333333e-3f + x2 * (-1.9841270e-4f + x2 * 2.7557319e-6f))));
    const float cp = 1.0f + x2 * (-0.5f + x2 * (4.1666667e-2f + x2 * (-1.3888889e-3f + x2 * (2.4801587e-5f + x2 * (-2.7557319e-7f)))));
    s = (q == 0) ? sp : (q == 1) ? cp : (q == 2) ? -sp : -cp;
    c = (q == 0) ? cp : (q == 1) ? -sp : (q == 2) ? -cp : sp;
}

struct Params {
    const float* in[14];
    float* out;
    unsigned char* ws;
    int ph_lo, ph_hi, use_cg, pad;
};

__device__ __forceinline__ void p0_prologue(const Params& p, LAS unsigned char* lds, int G, int bid) {
    const int tid = threadIdx.x, lane = tid & 63, wave = tid >> 6;
    const int gw = bid * 8 + wave, NGW = G * 8;
    LAS float* scr = (LAS float*)(lds + wave * 16384);
    const float* x = p.in[0]; const float* g1 = p.in[1]; const float* w_in = p.in[2];
    const float* w_s = p.in[6]; const float* w_out = p.in[8]; const float* g2 = p.in[9];
    const float* wg = p.in[10]; const float* wu = p.in[11]; const float* wd = p.in[12];
    bf16_t* W1 = (bf16_t*)(p.ws + WS_W1); bf16_t* W4 = (bf16_t*)(p.ws + WS_W4); bf16_t* W5 = (bf16_t*)(p.ws + WS_W5); bf16_t* W6 = (bf16_t*)(p.ws + WS_W6);
    constexpr int I1 = 16 * (NPROJ / 32), I4 = 16 * (DM / 32), I5 = 16 * (NFF2 / 32), I6 = (DFF / 64) * (DM / 32);
    for (int it = gw; it < I1 + I4 + I5 + I6; it += NGW) {
        int r = it;
        if (r < I1) { const int nb = r % (NPROJ / 32), kb = r / (NPROJ / 32), n0 = 32 * nb; int src = n0;
            if (n0 < 1024) { const int pn = n0 >> 8, pp = n0 & 255, bj = pp >> 7, rr = pp & 127, hh = rr >> 6, i = rr & 63; src = 256 * pn + 128 * hh + 64 * bj + i; }
            transpose_item(w_in, NPROJ, src, 64 * kb, nullptr, W1, DM, n0, scr, lane); continue; }
        r -= I1;
        if (r < I4) { const int nb = r % (DM / 32), kb = r / (DM / 32); transpose_item(w_out, DM, 32 * nb, 64 * kb, nullptr, W4, DM, 32 * nb, scr, lane); continue; }
        r -= I4;
        if (r < I5) { const int nb = r % (NFF2 / 32), kb = r / (NFF2 / 32), n0 = 32 * nb, pn = n0 >> 8, pp = n0 & 255, bj = pp >> 7, rr = pp & 127;
            transpose_item(bj ? wu : wg, DFF, 128 * pn + rr, 64 * kb, g2, W5, DM, n0, scr, lane); continue; }
        r -= I5;
        { const int nb = r % (DM / 32), kb = r / (DM / 32); transpose_item(wd, DM, 32 * nb, 64 * kb, nullptr, W6, DFF, 32 * nb, scr, lane); }
    }
    { bf16_t* WSb = (bf16_t*)(p.ws + WS_WS);
      for (int i = bid * 512 + tid; i < NG * GB * GB / 2; i += G * 512) { const int e = 2 * i, s = e & 127, t = (e >> 7) & 127; float a = w_s[e], b = w_s[e + 1]; if (t < 64 && s >= 64) { a = 0.f; b = 0.f; } ((unsigned*)WSb)[i] = cvt_pk_bf16(a, b); } }
    { f32x2* tab = (f32x2*)(p.ws + WS_ROPE);
      for (int i = bid * 512 + tid; i < SEQ * 64; i += G * 512) { const int pos = i >> 6, k = i & 63;
          const double inv = exp(-(double)k * (9.210340371976184 / 64.0));
          float s, c; sincos_d((double)pos * inv, s, c); tab[i] = (f32x2){c, s}; } }
    { bf16_t* XN = (bf16_t*)(p.ws + WS_XN);
      f32x4 gv[4];
#pragma unroll
      for (int j = 0; j < 4; ++j) gv[j] = ((const f32x4*)g1)[lane + 64 * j];
      for (int m = gw; m < M; m += NGW) {
          const f32x4* xr = (const f32x4*)(x + (size_t)m * DM) + lane; f32x4 v[4]; float s = 0.f;
#pragma unroll
          for (int j = 0; j < 4; ++j) { v[j] = xr[64 * j]; s += (v[j][0] * v[j][0] + v[j][1] * v[j][1]) + (v[j][2] * v[j][2] + v[j][3] * v[j][3]); }
          const float rstd = 1.0f / sqrtf(wave_sum(s) * (1.0f / DM) + EPS);
          u32x2* o = (u32x2*)(XN + (size_t)m * DM) + lane;
#pragma unroll
          for (int j = 0; j < 4; ++j) { u32x2 w; w.x = cvt_pk_bf16(v[j][0] * rstd * gv[j][0], v[j][1] * rstd * gv[j][1]); w.y = cvt_pk_bf16(v[j][2] * rstd * gv[j][2], v[j][3] * rstd * gv[j][3]); o[64 * j] = w; }
      } }
}

__device__ __forceinline__ void p2_gstats(const Params& p, int G, int bid) {
    const int tid = threadIdx.x, lane = tid & 63, wave = tid >> 6, gw = bid * 8 + wave, NGW = G * 8;
    const bf16_t* GV = (const bf16_t*)(p.ws + WS_Q + 5 * WS_SEG); f32x2* st = (f32x2*)(p.ws + WS_GST);
    for (int m = gw; m < M; m += NGW) {
        const u32x4 w = ((const u32x4*)(GV + (size_t)m * GW))[lane];
        float v[8] = {bflo(w.x), bfhi(w.x), bflo(w.y), bfhi(w.y), bflo(w.z), bfhi(w.z), bflo(w.w), bfhi(w.w)};
        float s = 0.f;
#pragma unroll
        for (int j = 0; j < 8; ++j) s += v[j];
        const float mean = wave_sum(s) * (1.0f / GW); float q = 0.f;
#pragma unroll
        for (int j = 0; j < 8; ++j) { const float d = v[j] - mean; q += d * d; }
        const float rstd = 1.0f / sqrtf(wave_sum(q) * (1.0f / GW) + EPS);
        if (lane == 0) st[m] = (f32x2){mean, rstd};
    }
}
__device__ __forceinline__ void p2_ret_naive(const Params& p, LAS unsigned char* lds, int G, int bid) {
    const int tid = threadIdx.x;
    const bf16_t* Q = (const bf16_t*)(p.ws + WS_Q); const bf16_t* Kb = (const bf16_t*)(p.ws + WS_Q + WS_SEG); const bf16_t* Vb = (const bf16_t*)(p.ws + WS_Q + 2 * WS_SEG);
    float* Y = (float*)(p.ws + WS_Y);
    LAS float* qs = (LAS float*)lds; LAS float* ks = qs + 64 * 129; LAS float* vs = ks + 64 * 129; LAS float* Ss = vs + 64 * 128;
    const int i = tid >> 3, eg = tid & 7;
    for (int item = bid; item < BATCH * NH * 64; item += G) {
        const int n = item & 63, bh = item >> 6, h = bh & 3, b = bh >> 2;
        const float l2g = log2f(1.0f - exp2f(-5.0f - (float)h));
        const size_t row0 = (size_t)b * SEQ + n * 64;
        __syncthreads();
        for (int idx = tid; idx < 64 * 128; idx += 512) { const int ii = idx >> 7, d = idx & 127; qs[ii * 129 + d] = bf2f(Q[(row0 + ii) * RW + h * HD + d]); }
        float acc[16];
#pragma unroll
        for (int e = 0; e < 16; ++e) acc[e] = 0.f;
        for (int mm = 0; mm <= n; ++mm) {
            const size_t rk0 = (size_t)b * SEQ + mm * 64;
            __syncthreads();
            for (int idx = tid; idx < 64 * 128; idx += 512) { const int jj = idx >> 7, d = idx & 127; ks[jj * 129 + d] = bf2f(Kb[(rk0 + jj) * RW + h * HD + d]); vs[jj * 128 + d] = bf2f(Vb[(rk0 + jj) * RW + h * HD + d]); }
            __syncthreads();
#pragma unroll 1
            for (int jj = 0; jj < 8; ++jj) { const int j = eg + 8 * jj; float dot = 0.f;
#pragma unroll 16
                for (int d = 0; d < 128; ++d) dot += qs[i * 129 + d] * ks[j * 129 + d];
                int dist = 64 * (n - mm) + i - j; dist = dist < 0 ? -dist : dist;
                Ss[i * 65 + j] = dot * exp2f(l2g * (float)(dist - (i + 1) - (63 - j))); }
            __syncthreads();
#pragma unroll 4
            for (int j = 0; j < 64; ++j) { const float s = Ss[i * 65 + j];
#pragma unroll
                for (int e = 0; e < 16; ++e) acc[e] += s * vs[j * 128 + e * 8 + eg]; }
        }
#pragma unroll
        for (int e = 0; e < 16; ++e) Y[(row0 + i) * RW + h * HD + e * 8 + eg] = acc[e];
    }
}


__device__ __forceinline__ void p2_gmlp(const Params& p, LAS unsigned char* lds, int G, int bid) {
    const int tid = threadIdx.x, lane = tid & 63, w = tid >> 6, l15 = lane & 15, l4 = lane >> 4;
    const bf16_t* GU = (const bf16_t*)(p.ws + WS_Q + 4 * WS_SEG); const bf16_t* GV = (const bf16_t*)(p.ws + WS_Q + 5 * WS_SEG);
    const bf16_t* WSb = (const bf16_t*)(p.ws + WS_WS); bf16_t* MIX = (bf16_t*)(p.ws + WS_MIX);
    const float* lng = p.in[4]; const float* lnb = p.in[5]; const float* b_s = p.in[7];
    for (int blk = bid; blk < M / GB; blk += G) {
        const size_t rb = (size_t)blk * GB;
        __syncthreads();
        {
            u32x4 raw[16];
#pragma unroll
            for (int r = 0; r < 16; ++r) raw[r] = *(const u32x4*)(GV + (rb + 16 * w + r) * GW + 8 * lane);
            const f32x4 lg0 = ((const f32x4*)lng)[2 * lane], lg1 = ((const f32x4*)lng)[2 * lane + 1], lb0 = ((const f32x4*)lnb)[2 * lane], lb1 = ((const f32x4*)lnb)[2 * lane + 1];
            const float lg[8] = {lg0[0], lg0[1], lg0[2], lg0[3], lg1[0], lg1[1], lg1[2], lg1[3]}, lb[8] = {lb0[0], lb0[1], lb0[2], lb0[3], lb1[0], lb1[1], lb1[2], lb1[3]};
#pragma unroll
            for (int kb = 0; kb < 2; ++kb) {
                float v[8][8];
#pragma unroll
                for (int rr = 0; rr < 8; ++rr) {
                    const u32x4 x = raw[8 * kb + rr];
                    v[rr][0] = bflo(x.x); v[rr][1] = bfhi(x.x); v[rr][2] = bflo(x.y); v[rr][3] = bfhi(x.y); v[rr][4] = bflo(x.z); v[rr][5] = bfhi(x.z); v[rr][6] = bflo(x.w); v[rr][7] = bfhi(x.w);
                    float sm = 0.f;
#pragma unroll
                    for (int cc = 0; cc < 8; ++cc) sm += v[rr][cc];
                    const float mean = wave_sum(sm) * (1.0f / GW); float q = 0.f;
#pragma unroll
                    for (int cc = 0; cc < 8; ++cc) { v[rr][cc] -= mean; q += v[rr][cc] * v[rr][cc]; }
                    const float rstd = 1.0f / sqrtf(wave_sum(q) * (1.0f / GW) + EPS);
#pragma unroll
                    for (int cc = 0; cc < 8; ++cc) v[rr][cc] = v[rr][cc] * rstd * lg[cc] + lb[cc];
                }
                const int g = l4, kbg = 2 * w + kb;
#pragma unroll
                for (int cc = 0; cc < 8; ++cc) {
                    u32x4 o; o.x = cvt_pk_bf16(v[0][cc], v[1][cc]); o.y = cvt_pk_bf16(v[2][cc], v[3][cc]); o.z = cvt_pk_bf16(v[4][cc], v[5][cc]); o.w = cvt_pk_bf16(v[6][cc], v[7][cc]);
                    const int ph = 8 * l15 + (cc ^ (l15 & 7));
                    *(LAS u32x4*)(lds + (((g * 16 + kbg) * 128 + ph) << 4)) = o;
                }
            }
        }
        __syncthreads();
        {
            const int g = w >> 1, chh = w & 1;
            f32x4 acc[2][2][8];
#pragma unroll
            for (int a = 0; a < 2; ++a)
#pragma unroll
                for (int n = 0; n < 2; ++n)
#pragma unroll
                    for (int ti = 0; ti < 8; ++ti) acc[a][n][ti] = (f32x4){0.f, 0.f, 0.f, 0.f};
            const bf16_t* wp = WSb + ((size_t)(g * 128 + l15) * 128 + 8 * l4);
#pragma unroll 1
            for (int ks = 0; ks < 4; ++ks) {
                bf16x8 X[2][2];
#pragma unroll
                for (int a = 0; a < 2; ++a)
#pragma unroll
                    for (int n = 0; n < 2; ++n) { const int c = 64 * chh + 32 * a + 8 * (l15 >> 2) + 4 * n + (l15 & 3), ph = c ^ ((c >> 3) & 7);
                        X[a][n] = *(const LAS bf16x8*)(lds + (((g * 16 + 4 * ks + l4) * 128 + ph) << 4)); }
#pragma unroll
                for (int ti = 0; ti < 8; ++ti) {
                    if (ti < 4 && ks >= 2) continue;
                    const bf16x8 Y = *(const bf16x8*)(wp + (size_t)(16 * ti) * 128 + 32 * ks);
#pragma unroll
                    for (int a = 0; a < 2; ++a)
#pragma unroll
                        for (int n = 0; n < 2; ++n) acc[a][n][ti] = __builtin_amdgcn_mfma_f32_16x16x32_bf16(X[a][n], Y, acc[a][n][ti], 0, 0, 0);
                }
            }
#pragma unroll
            for (int ti = 0; ti < 8; ++ti) {
                const int t = 16 * ti + l15; const float bsv = b_s[g * 128 + t];
#pragma unroll
                for (int a = 0; a < 2; ++a) {
                    const int ch0 = g * 128 + 64 * chh + 32 * a + 8 * l4;
                    const u32x4 gu = *(const u32x4*)(GU + (rb + t) * GW + ch0);
                    f32x4 o0, o1;
                    o0[0] = bflo(gu.x) * (acc[a][0][ti][0] + bsv); o0[1] = bfhi(gu.x) * (acc[a][0][ti][1] + bsv); o0[2] = bflo(gu.y) * (acc[a][0][ti][2] + bsv); o0[3] = bfhi(gu.y) * (acc[a][0][ti][3] + bsv);
                    o1[0] = bflo(gu.z) * (acc[a][1][ti][0] + bsv); o1[1] = bfhi(gu.z) * (acc[a][1][ti][1] + bsv); o1[2] = bflo(gu.w) * (acc[a][1][ti][2] + bsv); o1[3] = bfhi(gu.w) * (acc[a][1][ti][3] + bsv);
                    store8(MIX + (rb + t) * DM + RW + ch0, o0, o1);
                }
            }
        }
    }
}


typedef float f32x16 __attribute__((ext_vector_type(16)));
typedef short s16x4 __attribute__((ext_vector_type(4)));
#define MFMA32(a, b, c) __builtin_amdgcn_mfma_f32_32x32x16_bf16((a), (b), (c), 0, 0, 0)
constexpr size_t WS_T = 368 * MiB;
__device__ __forceinline__ unsigned off_a(unsigned row, unsigned ch) { return 2048u * (row >> 3) + 512u * (ch >> 2) + 64u * (row & 7u) + 16u * ((ch & 3u) ^ ((row >> 2) & 3u)); }
__device__ __forceinline__ int crow(int reg, int h) { return (reg & 3) + 8 * (reg >> 2) + 4 * h; }
template <int S> __device__ __forceinline__ bf16x8 pack8(const f32x16& x) {
    u32x4 p; p.x = cvt_pk_bf16(x[8 * S], x[8 * S + 1]); p.y = cvt_pk_bf16(x[8 * S + 2], x[8 * S + 3]); p.z = cvt_pk_bf16(x[8 * S + 4], x[8 * S + 5]); p.w = cvt_pk_bf16(x[8 * S + 6], x[8 * S + 7]);
    return __builtin_bit_cast(bf16x8, p);
}
__device__ __forceinline__ unsigned tr_lane_base(int lane, int t) {
    const unsigned h = lane >> 5, blk = (lane >> 4) & 1, q = (lane & 15) >> 2, p = lane & 3;
    return off_a(8u * t + 4u * h + q, 2u * blk + (p >> 1)) + 8u * (p & 1);
}
template <int COFF> __device__ __forceinline__ void tr_frags64(bf16x8 (&f)[4], unsigned b0, unsigned b1) {
    s16x4 x0, x1, x2, x3, x4, x5, x6, x7;
    asm volatile("ds_read_b64_tr_b16 %0, %8 offset:%10\n\tds_read_b64_tr_b16 %1, %9 offset:%10\n\tds_read_b64_tr_b16 %2, %8 offset:%11\n\tds_read_b64_tr_b16 %3, %9 offset:%11\n\t"
                 "ds_read_b64_tr_b16 %4, %8 offset:%12\n\tds_read_b64_tr_b16 %5, %9 offset:%12\n\tds_read_b64_tr_b16 %6, %8 offset:%13\n\tds_read_b64_tr_b16 %7, %9 offset:%13\n\ts_waitcnt lgkmcnt(0)"
                 : "=&v"(x0), "=&v"(x1), "=&v"(x2), "=&v"(x3), "=&v"(x4), "=&v"(x5), "=&v"(x6), "=&v"(x7)
                 : "v"(b0), "v"(b1), "i"(COFF), "i"(COFF + 4096), "i"(COFF + 8192), "i"(COFF + 12288) : "memory");
    f[0] = __builtin_shufflevector(x0, x1, 0, 1, 2, 3, 4, 5, 6, 7); f[1] = __builtin_shufflevector(x2, x3, 0, 1, 2, 3, 4, 5, 6, 7);
    f[2] = __builtin_shufflevector(x4, x5, 0, 1, 2, 3, 4, 5, 6, 7); f[3] = __builtin_shufflevector(x6, x7, 0, 1, 2, 3, 4, 5, 6, 7);
}

__device__ __forceinline__ void p2_tseg(const Params& p, LAS unsigned char* lds, int G, int bid) {
    const int tid = threadIdx.x, lane = tid & 63, w = tid >> 6, et = w & 3, dp = w >> 2;
    const bf16_t* Kb = (const bf16_t*)(p.ws + WS_Q + WS_SEG); const bf16_t* Vb = (const bf16_t*)(p.ws + WS_Q + 2 * WS_SEG);
    float* Tb = (float*)(p.ws + WS_T);
    const unsigned lbase = (unsigned)(size_t)lds;
    const unsigned tb0 = tr_lane_base(lane, 0), tb1 = tr_lane_base(lane, 1);
    for (int item = bid; item < BATCH * NH * 8; item += G) {
        const int seg = item & 7, bh = item >> 3, h = bh & 3, b = bh >> 2;
        const float cd = exp2f(64.0f * log2f(1.0f - exp2f(-5.0f - (float)h)));
        const size_t row0 = (size_t)b * SEQ + seg * 512;
        f32x16 T0, T1;
#pragma unroll
        for (int i = 0; i < 16; ++i) { T0[i] = 0.f; T1[i] = 0.f; }
        u32x4 stg[8];
#define TS_LOAD(st) do { _Pragma("unroll") for (int u = 0; u < 4; ++u) { const int c = tid + 512 * u, rr = c >> 4, ch = c & 15; const size_t go = (row0 + 128 * (st) + rr) * RW + h * HD + ch * 8; \
            stg[u] = *(const u32x4*)(Kb + go); stg[4 + u] = *(const u32x4*)(Vb + go); } } while (0)
#define TS_WRITE(buf) do { _Pragma("unroll") for (int u = 0; u < 4; ++u) { const int c = tid + 512 * u, rr = c >> 4, ch = c & 15; const unsigned o = (buf) * 65536u + (rr >> 6) * 16384u + off_a(rr & 63, ch); \
            *(LAS u32x4*)(lds + o) = stg[u]; *(LAS u32x4*)(lds + 32768u + o) = stg[4 + u]; } } while (0)
        __syncthreads();
        TS_LOAD(0); TS_WRITE(0);
#pragma unroll 1
        for (int st = 0; st < 4; ++st) {
            __syncthreads();
            if (st < 3) TS_LOAD(st + 1);
            const unsigned kb = lbase + (st & 1) * 65536u, vb = kb + 32768u + 512u * et;
#pragma unroll
            for (int cc = 0; cc < 2; ++cc) {
                bf16x8 vf[4], kf[4];
                tr_frags64<0>(vf, vb + cc * 16384u + tb0, vb + cc * 16384u + tb1);
                T0 = T0 * cd; T1 = T1 * cd;
                const unsigned k0 = kb + cc * 16384u + 1024u * dp;
                tr_frags64<0>(kf, k0 + tb0, k0 + tb1);
#pragma unroll
                for (int f = 0; f < 4; ++f) T0 = MFMA32(kf[f], vf[f], T0);
                tr_frags64<512>(kf, k0 + tb0, k0 + tb1);
#pragma unroll
                for (int f = 0; f < 4; ++f) T1 = MFMA32(kf[f], vf[f], T1);
            }
            if (st < 3) TS_WRITE((st + 1) & 1);
        }
#undef TS_LOAD
#undef TS_WRITE
        f32x4* o0 = (f32x4*)(Tb + ((size_t)(item * 16 + (2 * dp) * 4 + et) * 64 + lane) * 16);
        f32x4* o1 = (f32x4*)(Tb + ((size_t)(item * 16 + (2 * dp + 1) * 4 + et) * 64 + lane) * 16);
#pragma unroll
        for (int i = 0; i < 4; ++i) { o0[i] = (f32x4){T0[4 * i], T0[4 * i + 1], T0[4 * i + 2], T0[4 * i + 3]}; o1[i] = (f32x4){T1[4 * i], T1[4 * i + 1], T1[4 * i + 2], T1[4 * i + 3]}; }
    }
}

__device__ __forceinline__ void p3_retention(const Params& p, LAS unsigned char* lds, int G, int bid) {
    const int tid = threadIdx.x, lane = tid & 63, w = tid >> 6, et = w & 3, it = w >> 2, r = lane & 31, hh = lane >> 5;
    const bf16_t* Qg = (const bf16_t*)(p.ws + WS_Q); const bf16_t* Kg = (const bf16_t*)(p.ws + WS_Q + WS_SEG); const bf16_t* Vg = (const bf16_t*)(p.ws + WS_Q + 2 * WS_SEG);
    const bf16_t* SG = (const bf16_t*)(p.ws + WS_Q + 3 * WS_SEG); bf16_t* MIX = (bf16_t*)(p.ws + WS_MIX);
    const float* Tb = (const float*)(p.ws + WS_T); const float* gn = p.in[3];
    const unsigned lbase = (unsigned)(size_t)lds;
    constexpr unsigned OT_OFF = 98304u, OT_LD = 132u;
    const unsigned tb0 = tr_lane_base(lane, 0), tb1 = tr_lane_base(lane, 1);
    const unsigned rr0 = off_a(r, hh), rr1 = off_a(r, 2 + hh);
    const int ri = tid >> 3, part = tid & 7;
    for (int item = bid; item < BATCH * NH * 8; item += G) {
        const int seg = item & 7, bh = item >> 3, h = bh & 3, b = bh >> 2;
        const float l2g = log2f(1.0f - exp2f(-5.0f - (float)h)), cd = exp2f(64.0f * l2g);
        const size_t row0 = (size_t)b * SEQ + seg * 512;
        f32x16 St[4];
#pragma unroll
        for (int dt = 0; dt < 4; ++dt)
#pragma unroll
            for (int i = 0; i < 16; ++i) St[dt][i] = 0.f;
#pragma unroll 1
        for (int sp = 0; sp < seg; ++sp) {
            const float wgt = exp2f(512.0f * l2g * (float)(seg - 1 - sp));
#pragma unroll
            for (int dt = 0; dt < 4; ++dt) {
                const f32x4* tp = (const f32x4*)(Tb + ((size_t)((bh * 8 + sp) * 16 + dt * 4 + et) * 64 + lane) * 16);
#pragma unroll
                for (int i = 0; i < 4; ++i) { const f32x4 t = tp[i]; St[dt][4 * i] += wgt * t[0]; St[dt][4 * i + 1] += wgt * t[1]; St[dt][4 * i + 2] += wgt * t[2]; St[dt][4 * i + 3] += wgt * t[3]; }
            }
        }
        u32x4 stg[6], sgr[2];
#define RT_LOAD(c) do { _Pragma("unroll") for (int u = 0; u < 2; ++u) { const int cq = tid + 512 * u, rr = cq >> 4, ch = cq & 15; const size_t go = (row0 + 64 * (c) + rr) * RW + h * HD + ch * 8; \
            stg[u] = *(const u32x4*)(Qg + go); stg[2 + u] = *(const u32x4*)(Kg + go); stg[4 + u] = *(const u32x4*)(Vg + go); } } while (0)
#define RT_WRITE(buf) do { _Pragma("unroll") for (int u = 0; u < 2; ++u) { const int cq = tid + 512 * u, rr = cq >> 4, ch = cq & 15; const unsigned o = (buf) * 49152u + off_a(rr, ch); \
            *(LAS u32x4*)(lds + o) = stg[u]; *(LAS u32x4*)(lds + 16384u + o) = stg[2 + u]; *(LAS u32x4*)(lds + 32768u + o) = stg[4 + u]; } } while (0)
        __syncthreads();
        RT_LOAD(0); RT_WRITE(0);
#pragma unroll 1
        for (int c = 0; c < 8; ++c) {
            __syncthreads();
            if (c < 7) RT_LOAD(c + 1);
            { const size_t so = (row0 + 64 * c + ri) * RW + h * HD + 16 * part; sgr[0] = *(const u32x4*)(SG + so); sgr[1] = *(const u32x4*)(SG + so + 8); }
            const LAS unsigned char* Qb = lds + (c & 1) * 49152u + 8192u * it;
            const LAS unsigned char* Kb = lds + (c & 1) * 49152u + 16384u;
            const unsigned kbu = lbase + (c & 1) * 49152u + 16384u, vbu = kbu + 16384u + 512u * et;
            f32x16 X0, X1, O;
#pragma unroll
            for (int i = 0; i < 16; ++i) { X0[i] = 0.f; X1[i] = 0.f; O[i] = 0.f; }
#pragma unroll
            for (int ks = 0; ks < 8; ++ks) {
                const unsigned ro = ((ks & 1) ? rr1 : rr0) + 512u * (ks >> 1);
                const bf16x8 bq = *(const LAS bf16x8*)(Qb + ro);
                const bf16x8 a0 = *(const LAS bf16x8*)(Kb + ro), a1 = *(const LAS bf16x8*)(Kb + 8192u + ro);
                X0 = MFMA32(a0, bq, X0); X1 = MFMA32(a1, bq, X1);
                if (ks & 1) __builtin_amdgcn_sched_barrier(0);
            }
            { float ebase = __builtin_amdgcn_exp2f(2.0f * l2g * (float)(4 * hh - (32 * it + r)));
              asm volatile("" : "+v"(ebase));
              const float g2 = __builtin_amdgcn_exp2f(2.0f * l2g), g2_8 = __builtin_amdgcn_exp2f(16.0f * l2g), g2_32 = __builtin_amdgcn_exp2f(64.0f * l2g), cinv = __builtin_amdgcn_exp2f(-64.0f * l2g);
              float e0 = ebase, e1 = ebase * g2_32;
#pragma unroll
              for (int qd = 0; qd < 4; ++qd) {
                  float a = e0, bq2 = e1;
#pragma unroll
                  for (int k = 0; k < 4; ++k) { X0[4 * qd + k] *= cinv * fminf(1.0f, a); X1[4 * qd + k] *= cinv * fminf(1.0f, bq2); a *= g2; bq2 *= g2; }
                  e0 *= g2_8; e1 *= g2_8;
              } }
            const bf16x8 P00 = pack8<0>(X0), P01 = pack8<1>(X0), P10 = pack8<0>(X1), P11 = pack8<1>(X1);
            __builtin_amdgcn_sched_barrier(0);
            bf16x8 vf[4];
            tr_frags64<0>(vf, vbu + tb0, vbu + tb1);
            O = MFMA32(vf[0], P00, O); O = MFMA32(vf[1], P01, O); O = MFMA32(vf[2], P10, O); O = MFMA32(vf[3], P11, O);
            __builtin_amdgcn_sched_barrier(0);
#pragma unroll
            for (int dt = 0; dt < 4; ++dt) {
                const s16x4 l0 = *(const LAS s16x4*)(Qb + off_a(r, 4 * dt + 0) + 8 * hh), h0 = *(const LAS s16x4*)(Qb + off_a(r, 4 * dt + 1) + 8 * hh);
                const s16x4 l1 = *(const LAS s16x4*)(Qb + off_a(r, 4 * dt + 2) + 8 * hh), h1 = *(const LAS s16x4*)(Qb + off_a(r, 4 * dt + 3) + 8 * hh);
                const bf16x8 q0 = __builtin_shufflevector(l0, h0, 0, 1, 2, 3, 4, 5, 6, 7), q1 = __builtin_shufflevector(l1, h1, 0, 1, 2, 3, 4, 5, 6, 7);
                O = MFMA32(pack8<0>(St[dt]), q0, O); O = MFMA32(pack8<1>(St[dt]), q1, O);
                if (dt & 1) __builtin_amdgcn_sched_barrier(0);
            }
            {
                bf16x8 kf[4];
                tr_frags64<0>(kf, kbu + tb0, kbu + tb1);
                St[0] = St[0] * cd;
#pragma unroll
                for (int f = 0; f < 4; ++f) St[0] = MFMA32(kf[f], vf[f], St[0]);
                tr_frags64<512>(kf, kbu + tb0, kbu + tb1);
                St[1] = St[1] * cd;
#pragma unroll
                for (int f = 0; f < 4; ++f) St[1] = MFMA32(kf[f], vf[f], St[1]);
                tr_frags64<1024>(kf, kbu + tb0, kbu + tb1);
                St[2] = St[2] * cd;
#pragma unroll
                for (int f = 0; f < 4; ++f) St[2] = MFMA32(kf[f], vf[f], St[2]);
                tr_frags64<1536>(kf, kbu + tb0, kbu + tb1);
                St[3] = St[3] * cd;
#pragma unroll
                for (int f = 0; f < 4; ++f) St[3] = MFMA32(kf[f], vf[f], St[3]);
            }
            __builtin_amdgcn_sched_barrier(0);
            { LAS float* ot = (LAS float*)(lds + OT_OFF) + (32 * it + r) * OT_LD + 32 * et + 4 * hh;
#pragma unroll
              for (int qd = 0; qd < 4; ++qd) *(LAS f32x4*)(ot + 8 * qd) = (f32x4){O[4 * qd], O[4 * qd + 1], O[4 * qd + 2], O[4 * qd + 3]}; }
            __syncthreads();
            { const LAS f32x4* op = (const LAS f32x4*)((const LAS float*)(lds + OT_OFF) + ri * OT_LD + 16 * part);
              f32x4 o[4]; float sm = 0.f;
#pragma unroll
              for (int u = 0; u < 4; ++u) { o[u] = op[u]; sm += (o[u][0] + o[u][1]) + (o[u][2] + o[u][3]); }
              sm += __shfl_xor(sm, 1); sm += __shfl_xor(sm, 2); sm += __shfl_xor(sm, 4);
              const float mean = sm * (1.0f / HD); float q = 0.f;
#pragma unroll
              for (int u = 0; u < 4; ++u) { o[u] = o[u] - mean; q += (o[u][0] * o[u][0] + o[u][1] * o[u][1]) + (o[u][2] * o[u][2] + o[u][3] * o[u][3]); }
              q += __shfl_xor(q, 1); q += __shfl_xor(q, 2); q += __shfl_xor(q, 4);
              const float rstd = 1.0f / sqrtf(q * (1.0f / HD) + EPS);
              const f32x4* gp = (const f32x4*)(gn + h * HD + 16 * part);
              const unsigned sw[8] = {sgr[0].x, sgr[0].y, sgr[0].z, sgr[0].w, sgr[1].x, sgr[1].y, sgr[1].z, sgr[1].w};
#pragma unroll
              for (int u = 0; u < 4; ++u) { const f32x4 g4 = gp[u];
                  o[u][0] = o[u][0] * rstd * g4[0] * bflo(sw[2 * u]); o[u][1] = o[u][1] * rstd * g4[1] * bfhi(sw[2 * u]);
                  o[u][2] = o[u][2] * rstd * g4[2] * bflo(sw[2 * u + 1]); o[u][3] = o[u][3] * rstd * g4[3] * bfhi(sw[2 * u + 1]); }
              bf16_t* mp = MIX + (row0 + 64 * c + ri) * DM + h * HD + 16 * part;
              store8(mp, o[0], o[1]); store8(mp + 8, o[2], o[3]); }
            if (c < 7) RT_WRITE((c + 1) & 1);
        }
#undef RT_LOAD
#undef RT_WRITE
    }
}

__device__ __forceinline__ void p3_gn_gate(const Params& p, int G, int bid) {
    const int tid = threadIdx.x, lane = tid & 63, wave = tid >> 6, gw = bid * 8 + wave, NGW = G * 8;
    const float* Y = (const float*)(p.ws + WS_Y); const bf16_t* SG = (const bf16_t*)(p.ws + WS_Q + 3 * WS_SEG); bf16_t* MIX = (bf16_t*)(p.ws + WS_MIX);
    const float* gn = p.in[3];
    const f32x4 g0 = ((const f32x4*)gn)[2 * lane], g1 = ((const f32x4*)gn)[2 * lane + 1];
    for (int m = gw; m < M; m += NGW) {
        const f32x4 a = ((const f32x4*)(Y + (size_t)m * RW))[2 * lane], b = ((const f32x4*)(Y + (size_t)m * RW))[2 * lane + 1];
        float s = (a[0] + a[1]) + (a[2] + a[3]) + (b[0] + b[1]) + (b[2] + b[3]);
        s += __shfl_xor(s, 1); s += __shfl_xor(s, 2); s += __shfl_xor(s, 4); s += __shfl_xor(s, 8);
        const float mean = s * (1.0f / HD);
        const f32x4 da = a - mean, db = b - mean;
        float q = (da[0] * da[0] + da[1] * da[1]) + (da[2] * da[2] + da[3] * da[3]) + (db[0] * db[0] + db[1] * db[1]) + (db[2] * db[2] + db[3] * db[3]);
        q += __shfl_xor(q, 1); q += __shfl_xor(q, 2); q += __shfl_xor(q, 4); q += __shfl_xor(q, 8);
        const float rstd = 1.0f / sqrtf(q * (1.0f / HD) + EPS);
        const u32x4 sg = ((const u32x4*)(SG + (size_t)m * RW))[lane];
        f32x4 o0, o1;
        o0[0] = da[0] * rstd * g0[0] * bflo(sg.x); o0[1] = da[1] * rstd * g0[1] * bfhi(sg.x); o0[2] = da[2] * rstd * g0[2] * bflo(sg.y); o0[3] = da[3] * rstd * g0[3] * bfhi(sg.y);
        o1[0] = db[0] * rstd * g1[0] * bflo(sg.z); o1[1] = db[1] * rstd * g1[1] * bfhi(sg.z); o1[2] = db[2] * rstd * g1[2] * bflo(sg.w); o1[3] = db[3] * rstd * g1[3] * bfhi(sg.w);
        store8(MIX + (size_t)m * DM + 8 * lane, o0, o1);
    }
}
__device__ __forceinline__ void p3_gmlp_naive(const Params& p, LAS unsigned char* lds, int G, int bid) {
    const int tid = threadIdx.x;
    const bf16_t* GU = (const bf16_t*)(p.ws + WS_Q + 4 * WS_SEG); const bf16_t* GV = (const bf16_t*)(p.ws + WS_Q + 5 * WS_SEG);
    const f32x2* st = (const f32x2*)(p.ws + WS_GST); bf16_t* MIX = (bf16_t*)(p.ws + WS_MIX);
    const float* lng = p.in[4]; const float* lnb = p.in[5]; const float* w_s = p.in[6]; const float* b_s = p.in[7];
    LAS float* vn = (LAS float*)lds; LAS float* wl = vn + 128 * 128;
    const int c = tid & 127, tg = tid >> 7;
    for (int item = bid; item < (M / GB) * NG; item += G) {
        const int g = item & 3, blk = item >> 2; const size_t rb = (size_t)blk * GB; const int ch = g * 128 + c;
        __syncthreads();
        const float lg = lng[ch], lb = lnb[ch];
        for (int s = tg; s < 128; s += 4) { const f32x2 ms = st[rb + s]; vn[s * 128 + c] = (bf2f(GV[(rb + s) * GW + ch]) - ms[0]) * ms[1] * lg + lb; }
        for (int idx = tid; idx < 128 * 128; idx += 512) wl[idx] = w_s[(size_t)g * 128 * 128 + idx];
        __syncthreads();
        for (int tt = 0; tt < 32; ++tt) { const int t = tg * 32 + tt; const int smax = (t < 64) ? 64 : 128; float sum = 0.f;
            for (int s = 0; s < smax; ++s) sum += wl[t * 128 + s] * vn[s * 128 + c];
            const float mixed = sum + b_s[g * 128 + t];
            const float o = bf2f(GU[(rb + t) * GW + ch]) * mixed;
            MIX[(rb + t) * DM + RW + ch] = (bf16_t)(cvt_pk_bf16(o, 0.f) & 0xffffu); }
    }
}

__device__ __forceinline__ void p7_final(const Params& p, int G, int bid) {
    const int tid = threadIdx.x, lane = tid & 63, wave = tid >> 6, gw = bid * 8 + wave, NGW = G * 8;
    const float* ss = (const float*)(p.ws + WS_SS2); const float* fg = p.in[13];
    f32x4 gv[4];
#pragma unroll
    for (int j = 0; j < 4; ++j) gv[j] = ((const f32x4*)fg)[lane + 64 * j];
    for (int m = gw; m < M; m += NGW) {
        const float rs = row_rstd(ss, m);
        f32x4* xr = (f32x4*)(p.out + (size_t)m * DM) + lane;
#pragma unroll
        for (int j = 0; j < 4; ++j) { f32x4 v = xr[64 * j]; v = v * rs * gv[j]; xr[64 * j] = v; }
    }
}

#define XB_TMO      128
#define XB_XCNT(j)  (256  + 64 * (j))
#define XB_XSUB(j)  (1280 + 64 * (j))
#define XB_XGEN(j)  (2304 + 64 * (j))
#define XB_TOP      3328
#define XB_TOPGEN   3392
#define XCD_BAR_WORDS 3456
#define XB_SPIN_CAP (1u << 18)

__device__ __forceinline__ unsigned xb_ld(unsigned* p)              { return __hip_atomic_load(p, __ATOMIC_RELAXED, __HIP_MEMORY_SCOPE_AGENT); }
__device__ __forceinline__ unsigned xb_add(unsigned* p, unsigned v) { return __hip_atomic_fetch_add(p, v, __ATOMIC_RELAXED, __HIP_MEMORY_SCOPE_AGENT); }
__device__ __forceinline__ unsigned xb_xcc_id() { return (unsigned)__builtin_amdgcn_s_getreg((3 << 11) | 20) & 0xFu; }
#define XB_SPIN(cond, bar) do { unsigned _sp = 0; while (cond) { __builtin_amdgcn_s_sleep(1); \
    if ((++_sp & 255u) == 0u) { if (xb_ld(&(bar)[XB_TMO])) break; if (_sp > XB_SPIN_CAP) { atomicAdd(&(bar)[XB_TMO], 1u); break; } } } } while (0)

struct XcdBarrier {
    unsigned* bar; unsigned x;
    volatile LAS unsigned* st;
};

__device__ __forceinline__ XcdBarrier xcd_barrier_post(unsigned* bar, volatile LAS unsigned* st) {
    XcdBarrier b; b.bar = bar; b.x = xb_xcc_id(); b.st = st;
    if (threadIdx.x == 0) (void)xb_add(&bar[XB_XCNT(b.x)], 1u);
    return b;
}
__device__ __forceinline__ void xcd_barrier_complete(unsigned* bar, unsigned x, unsigned& nloc, unsigned& nx) {
    const unsigned G = gridDim.x * gridDim.y * gridDim.z;
    unsigned sum, cnt, mine, sp = 0u;
    for (;;) {
        sum = 0u; cnt = 0u; mine = 0u;
#pragma unroll
        for (unsigned j = 0; j < 16; ++j) { const unsigned c = xb_ld(&bar[XB_XCNT(j)]); sum += c; cnt += (c > 0u) ? 1u : 0u; mine = (j == x) ? c : mine; }
        if (sum == G) break;
        __builtin_amdgcn_s_sleep(1);
        if ((++sp & 255u) == 0u) { if (xb_ld(&bar[XB_TMO])) break; if (sp > XB_SPIN_CAP) { atomicAdd(&bar[XB_TMO], 1u); break; } }
    }
    nloc = mine > 0u ? mine : 1u; nx = cnt > 0u ? cnt : 1u;
}

__device__ __forceinline__ void xcd_barrier(const XcdBarrier& b) {
    asm volatile("s_waitcnt vmcnt(0)" ::: "memory");
    __syncthreads();
    if (threadIdx.x == 0) {
        unsigned* bar = b.bar;
        __builtin_amdgcn_s_waitcnt(0);
        unsigned nloc = b.st[0], nx = b.st[1];
        if (nloc == 0u) { xcd_barrier_complete(bar, b.x, nloc, nx); b.st[0] = nloc; b.st[1] = nx; }
        const unsigned old = xb_add(&bar[XB_XSUB(b.x)], 1u);
        const unsigned gen = old / nloc;
        if (old + 1u == (gen + 1u) * nloc) {
            __builtin_amdgcn_fence(__ATOMIC_RELEASE, "agent");
            asm volatile("s_waitcnt vmcnt(0)" ::: "memory");
            const unsigned og = xb_add(&bar[XB_TOP], 1u);
            const unsigned tg = og / nx;
            if (og + 1u == (tg + 1u) * nx) xb_add(&bar[XB_TOPGEN], 1u);
            else XB_SPIN(xb_ld(&bar[XB_TOPGEN]) == tg, bar);
            __builtin_amdgcn_fence(__ATOMIC_ACQUIRE, "agent");
            xb_add(&bar[XB_XGEN(b.x)], 1u);
            asm volatile("s_waitcnt vmcnt(0)" ::: "memory");
        } else {
            XB_SPIN(xb_ld(&bar[XB_XGEN(b.x)]) == gen, bar);
            __builtin_amdgcn_fence(__ATOMIC_ACQUIRE, "agent");
            asm volatile("s_waitcnt vmcnt(0)" ::: "memory");
        }
    }
    __syncthreads();
}

__global__ void __launch_bounds__(512, 2) fwd_kernel(Params p) {
    extern __shared__ __attribute__((aligned(16))) unsigned char lds_raw[];
    LAS unsigned char* lds = (LAS unsigned char*)lds_raw;
    const int G = gridDim.x, bid = blockIdx.x;
    unsigned char* ws = p.ws;
    const int lo = p.ph_lo, hi = p.ph_hi;
    { volatile LAS unsigned* st = (volatile LAS unsigned*)(lds + LDS_BYTES - 64); if (threadIdx.x < 2) st[threadIdx.x] = 0u; __syncthreads(); }
    const XcdBarrier bar = xcd_barrier_post((unsigned*)ws, (volatile LAS unsigned*)(lds + LDS_BYTES - 64));
#define IN(k) (lo <= (k) && (k) < hi)
#define SEAM(k) do { if (IN(k) && IN((k) + 1)) { if (p.use_cg) cg::this_grid().sync(); else xcd_barrier(bar); } } while (0)
    if (IN(0)) { p0_prologue(p, lds, G, bid); }
    SEAM(0);
    if (IN(1)) { EpiProj E{(bf16_t*)(ws + WS_Q), (const f32x2*)(ws + WS_ROPE)};
                 Gemm g{(const bf16_t*)(ws + WS_XN), (const bf16_t*)(ws + WS_W1), M, NPROJ, DM}; StaticOrder S; S.init(M, NPROJ, G, bid); gemm_phase<EpiProj, StaticOrder, true, true>(lds, g, S, E); }
    SEAM(1);
    if (IN(2)) { p2_tseg(p, lds, G, bid); p2_gmlp(p, lds, G, bid); }
    SEAM(2);
    if (IN(3)) { p3_retention(p, lds, G, bid); }
    SEAM(3);
    if (IN(4)) { EpiResid E{p.in[0], p.out, (bf16_t*)(ws + WS_XN), (float*)(ws + WS_SS1)};
                 Gemm g{(const bf16_t*)(ws + WS_MIX), (const bf16_t*)(ws + WS_W4), M, DM, DM}; StaticOrder S; S.init(M, DM, G, bid); gemm_phase<EpiResid, StaticOrder, true, true>(lds, g, S, E); }
    SEAM(4);
    if (IN(5)) { EpiSwiglu E{(bf16_t*)(ws + WS_HID), (const float*)(ws + WS_SS1)};
                 Gemm g{(const bf16_t*)(ws + WS_XN), (const bf16_t*)(ws + WS_W5), M, NFF2, DM}; StaticOrder S; S.init(M, NFF2, G, bid); gemm_phase<EpiSwiglu, StaticOrder, true, true>(lds, g, S, E); }
    SEAM(5);
    if (IN(6)) { EpiResid E{p.out, p.out, nullptr, (float*)(ws + WS_SS2)};
                 Gemm g{(const bf16_t*)(ws + WS_HID), (const bf16_t*)(ws + WS_W6), M, DM, DFF}; StaticOrder S; S.init(M, DM, G, bid); gemm_phase<EpiResid, StaticOrder, true, true>(lds, g, S, E); }
    SEAM(6);
    if (IN(7)) { p7_final(p, G, bid); }
#undef IN
#undef SEAM
}

extern "C" void kernel_launch(void* const* d_in, const int* in_sizes, int n_in, void* d_out, int out_size, void* d_ws, size_t ws_size, hipStream_t stream) {
    static int grid = 0;
    if (grid == 0) {
        if (n_in != 14 || in_sizes[0] != M * DM || out_size != M * DM || ws_size < WS_END) { fprintf(stderr, "kernel_launch: unexpected shapes (n_in %d, in0 %d, out %d, ws %zu)\n", n_in, n_in > 0 ? in_sizes[0] : -1, out_size, ws_size); grid = -1; return; }
        int dev = 0, cus = 0, per_cu = 0;
        (void)hipGetDevice(&dev); (void)hipDeviceGetAttribute(&cus, hipDeviceAttributeMultiprocessorCount, dev);
        (void)hipFuncSetAttribute((const void*)fwd_kernel, hipFuncAttributeMaxDynamicSharedMemorySize, LDS_BYTES);
        (void)hipOccupancyMaxActiveBlocksPerMultiprocessor(&per_cu, (const void*)fwd_kernel, 512, LDS_BYTES);
        if (per_cu < 1) { fprintf(stderr, "kernel_launch: occupancy query says %d blocks per CU\n", per_cu); per_cu = 1; }
        if (per_cu > 1) per_cu = 1;
        grid = cus * per_cu;
        (void)hipGetLastError();
    }
    if (grid < 0) return;
    if (hipMemsetAsync(d_ws, 0, 16384, stream) != hipSuccess) { fprintf(stderr, "kernel_launch: memset of the barrier words failed\n"); return; }
    Params p{};
    for (int i = 0; i < 14; ++i) p.in[i] = (const float*)d_in[i];
    p.out = (float*)d_out; p.ws = (unsigned char*)d_ws;
    const int per = NPHASE / N_LAUNCHES;
    for (int li = 0; li < N_LAUNCHES; ++li) {
        p.ph_lo = li * per; p.ph_hi = (li == N_LAUNCHES - 1) ? NPHASE : (li + 1) * per;
        void* args[] = {&p};
        hipError_t e = hipLaunchCooperativeKernel((const void*)fwd_kernel, dim3(grid), dim3(512), args, LDS_BYTES, stream);
        if (e != hipSuccess) { fprintf(stderr, "kernel_launch: cooperative launch %d failed: %s (grid %d)\n", li, hipGetErrorString(e), grid); break; }
    }
}
```

```cpp
#include <hip/hip_runtime.h>
#include <hip/hip_cooperative_groups.h>
#include <cstdio>
#include <cstdint>
namespace cg = cooperative_groups;

#ifndef N_LAUNCHES
#define N_LAUNCHES 1
#endif

#define LAS __attribute__((address_space(3)))
typedef unsigned short bf16_t;
typedef short bf16x8 __attribute__((ext_vector_type(8)));
typedef float f32x4 __attribute__((ext_vector_type(4)));
typedef float f32x2 __attribute__((ext_vector_type(2)));
typedef unsigned u32x4 __attribute__((ext_vector_type(4)));
typedef unsigned u32x2 __attribute__((ext_vector_type(2)));

constexpr int BATCH = 8, SEQ = 4096, DM = 1024, M = BATCH * SEQ;
constexpr int RW = 512, HD = 128, NH = 4, GW = 512, GB = 128, NG = 4, CHUNK = 64;
constexpr int NPROJ = 3072, DFF = 2816, NFF2 = 2 * DFF;
constexpr float EPS = 1e-6f;
constexpr int NPHASE = 8;

constexpr size_t MiB = 1u << 20;
constexpr size_t WS_W1 = 2 * MiB;
constexpr size_t WS_W4 = 8 * MiB;
constexpr size_t WS_W5 = 10 * MiB;
constexpr size_t WS_W6 = 22 * MiB;
constexpr size_t WS_WS = 28 * MiB;
constexpr size_t WS_SS1 = 29 * MiB;
constexpr size_t WS_SS2 = 31 * MiB;
constexpr size_t WS_ROPE = 33 * MiB;
constexpr size_t WS_GST = 35 * MiB;
constexpr size_t WS_XN = 48 * MiB;
constexpr size_t WS_Q = 112 * MiB;
constexpr size_t WS_SEG = 32 * MiB;
constexpr size_t WS_HID = 112 * MiB;
constexpr size_t WS_MIX = 304 * MiB;
constexpr size_t WS_Y = 368 * MiB;
constexpr size_t WS_END = 432 * MiB;

constexpr int LDS_BYTES = 147456;

typedef __bf16 bf16x2_t __attribute__((ext_vector_type(2)));
__device__ __forceinline__ unsigned cvt_pk_bf16(float lo, float hi) { bf16x2_t v = {(__bf16)lo, (__bf16)hi}; return __builtin_bit_cast(unsigned, v); }
__device__ __forceinline__ float bf2f(bf16_t b) { return __uint_as_float(((unsigned)b) << 16); }
__device__ __forceinline__ float bflo(unsigned w) { return __uint_as_float(w << 16); }
__device__ __forceinline__ float bfhi(unsigned w) { return __uint_as_float(w & 0xffff0000u); }
__device__ __forceinline__ float wave_sum(float v) {
#pragma unroll
    for (int o = 1; o < 64; o <<= 1) v += __shfl_xor(v, o);
    return v;
}
__device__ __forceinline__ float sigmoidf_(float x) { return __builtin_amdgcn_rcpf(1.0f + __builtin_amdgcn_exp2f(-1.4426950408889634f * x)); }
__device__ __forceinline__ float silu_(float x) { return x * sigmoidf_(x); }
__device__ __forceinline__ float gelu_(float x) { const float z = 1.5957691216057308f * (x + 0.044715f * x * x * x); return x * sigmoidf_(z); }

#define PG8_LAS LAS
constexpr int BM = 256, BK = 64, HALF = 128, HTB = HALF * BK * 2  , STAGE_BYTES = 8 * HTB, NXCD = 8, WGM = 8;

__host__ __device__ __forceinline__ int lds_byte(int r, int c) { const int st = (r >> 4) * 2 + (c >> 5), rr = r & 15, cc = c & 31, ob = rr * 64 + cc * 2; return st * 1024 + (ob ^ (((ob >> 9) & 1) << 5)); }
__host__ __device__ __forceinline__ void stage_rc(int b, int& R, int& C) { const int st = b / 1024, sb = b % 1024, swz = sb ^ (((sb >> 9) & 1) << 5); R = (st >> 1) * 16 + swz / 64; C = (st & 1) * 32 + (swz % 64) / 2; }
__host__ __device__ __forceinline__ int perm32(int rho) { const int n = rho >> 4, i = rho & 15; return 8 * (i >> 2) + 4 * n + (i & 3); }
struct Unit { int pm, pn; };
struct StaticOrder {
    int nM, nN, nwg, G, c;
    __host__ __device__ void init(int M_, int N_, int G_, int c_) { nM = M_ / BM; nN = N_ / BM; nwg = nM * nN; G = G_; c = c_; }
    __host__ __device__ bool next(int i, Unit& u) const {
        const long L = (long)i * G + c; if (L >= nwg) return false;
        int wgid = (int)L; { const int q = nwg / NXCD, r = nwg % NXCD, xcd = wgid % NXCD, off = wgid / NXCD; wgid = (xcd < r ? xcd * (q + 1) : r * (q + 1) + (xcd - r) * q) + off; }
        const int nig = WGM * nN, gid = wgid / nig, fm = gid * WGM, gsz = (nM - fm) < WGM ? (nM - fm) : WGM;
        u.pm = fm + ((wgid % nig) % gsz); u.pn = (wgid % nig) / gsz; return true;
    }
    __device__ __forceinline__ void a_ready(const Unit&) const {}
    __device__ __forceinline__ void done(const Unit&) const {}
};
struct Gemm { const bf16_t* A; const bf16_t* Bt; int M, N, K; };

typedef f32x4 Acc[2][2][4][2];

template <class Epi, class Sched, bool ALIGN_EPI = false, bool SP2 = false>
__device__ __forceinline__ void gemm_phase(PG8_LAS unsigned char* lds, const Gemm g, const Sched& S, const Epi& E) {
    const int tid = threadIdx.x, wid = __builtin_amdgcn_readfirstlane(tid >> 6), lane = tid & 63, wr = wid >> 2, wc = wid & 3, fr = lane & 15, fq = lane >> 4;
    const int K = g.K, nt = K / BK;
    unsigned voffA[2], voffB[2];
#pragma unroll
    for (int i = 0; i < 2; ++i) { int R, C; stage_rc(tid * 16 + i * 8192, R, C); const int Rb = Epi::PERM ? ((R & ~31) + perm32(R & 31)) : R;
        voffA[i] = (unsigned)(R * K + C) * 2u; voffB[i] = (unsigned)(Rb * K + C) * 2u; }
    const size_t kstep = (size_t)(BK * 2);
    const size_t hstep = (size_t)HALF * K * 2;
    const size_t tstep = 2 * hstep;
    const unsigned ldsw = (unsigned)wid * 1024u;
    const int aoff = lds_byte(wr * 64 + fr, fq * 8), boff = lds_byte(wc * 32 + fr, fq * 8);
#define PG8_SA(b, h) (((b) * 2 + (h)) * HTB)
#define PG8_SB(b, h) ((4 + (b) * 2 + (h)) * HTB)
#define PG8_STAGE(bufoff, gbase, voff) do { _Pragma("unroll") for (int _i = 0; _i < 2; ++_i) \
        __builtin_amdgcn_global_load_lds((const unsigned*)((const char*)(gbase) + (voff)[_i]), (PG8_LAS unsigned*)(lds + (bufoff) + ldsw + _i * 8192), 16, 0, 0); } while (0)
#define PG8_LDA(dst, b, h) do { _Pragma("unroll") for (int m = 0; m < 4; ++m) _Pragma("unroll") for (int k = 0; k < 2; ++k) dst[m][k] = *(const PG8_LAS bf16x8*)(lds + PG8_SA(b, h) + aoff + m * 2048 + k * 1024); } while (0)
#define PG8_LDB(dst, b, h) do { _Pragma("unroll") for (int n = 0; n < 2; ++n) _Pragma("unroll") for (int k = 0; k < 2; ++k) dst[n][k] = *(const PG8_LAS bf16x8*)(lds + PG8_SB(b, h) + boff + n * 2048 + k * 1024); } while (0)
#define PG8_MMA(ai, bj, At, Bt) do { __builtin_amdgcn_s_setprio(1); _Pragma("unroll") for (int m = 0; m < 4; ++m) _Pragma("unroll") for (int n = 0; n < 2; ++n) _Pragma("unroll") for (int k = 0; k < 2; ++k) \
        acc[ai][bj][m][n] = __builtin_amdgcn_mfma_f32_16x16x32_bf16(Bt[n][k], At[m][k], acc[ai][bj][m][n], 0, 0, 0); __builtin_amdgcn_s_setprio(0); } while (0)
#define PG8_WAIT_V(n) asm volatile("s_waitcnt vmcnt(" #n ")" ::: "memory")
#define PG8_WAIT_L(n) asm volatile("s_waitcnt lgkmcnt(" #n ")" ::: "memory")
#define PG8_BAR __builtin_amdgcn_s_barrier()
#define PG8_SCHED __builtin_amdgcn_sched_barrier(0)
    Unit cur, nxt; int ui = 0;
    if (!S.next(0, cur)) return;
    f32x4 acc[2][2][4][2];
#pragma unroll
    for (int a = 0; a < 2; ++a)
#pragma unroll
        for (int b = 0; b < 2; ++b)
#pragma unroll
            for (int m = 0; m < 4; ++m)
#pragma unroll
                for (int n = 0; n < 2; ++n) acc[a][b][m][n] = (f32x4){0.f, 0.f, 0.f, 0.f};
    bf16x8 At[4][2], B0[2][2], B1[2][2];
    const char* cA = (const char*)g.A + (size_t)cur.pm * tstep; const char* cB = (const char*)g.Bt + (size_t)cur.pn * tstep;
    S.a_ready(cur);
    if constexpr (SP2) {
        PG8_STAGE(PG8_SB(0, 0), cB, voffB); PG8_STAGE(PG8_SB(0, 1), cB + hstep, voffB); PG8_STAGE(PG8_SA(0, 0), cA, voffA); PG8_STAGE(PG8_SA(0, 1), cA + hstep, voffA);
        if (wr == 1) PG8_BAR;
        PG8_WAIT_V(2); PG8_BAR;
        PG8_STAGE(PG8_SB(1, 0), cB + kstep, voffB); PG8_STAGE(PG8_SA(1, 0), cA + kstep, voffA); PG8_STAGE(PG8_SB(1, 1), cB + hstep + kstep, voffB);
        PG8_WAIT_V(6); PG8_BAR;
    } else {
        PG8_STAGE(PG8_SB(0, 0), cB, voffB); PG8_STAGE(PG8_SA(0, 0), cA, voffA); PG8_STAGE(PG8_SB(0, 1), cB + hstep, voffB); PG8_STAGE(PG8_SA(0, 1), cA + hstep, voffA);
        if (wr == 1) PG8_BAR;
        PG8_WAIT_V(4); PG8_BAR;
        PG8_STAGE(PG8_SB(1, 0), cB + kstep, voffB); PG8_STAGE(PG8_SA(1, 0), cA + kstep, voffA); PG8_STAGE(PG8_SB(1, 1), cB + hstep + kstep, voffB);
        PG8_WAIT_V(6); PG8_BAR;
    }
    for (;;) {
        const bool has_next = S.next(ui + 1, nxt);
        const char* nA = has_next ? (const char*)g.A + (size_t)nxt.pm * tstep : cA; const char* nB = has_next ? (const char*)g.Bt + (size_t)nxt.pn * tstep : cB;
        for (int t = 0; t < nt; t += 2) {
            const bool last = (t == nt - 2);
            const char* a1 = cA + (size_t)(t + 1) * kstep;
            const char* a2 = last ? nA : cA + (size_t)(t + 2) * kstep; const char* b2 = last ? nB : cB + (size_t)(t + 2) * kstep;
            const char* a3 = a2 + kstep; const char* b3 = b2 + kstep;
            if (last && has_next) S.a_ready(nxt);
            if constexpr (SP2) {
            PG8_LDB(B0, 0, 0); PG8_LDB(B1, 0, 1); PG8_SCHED; PG8_LDA(At, 0, 0); PG8_STAGE(PG8_SA(1, 1), a1 + hstep, voffA);
            PG8_WAIT_V(8); PG8_WAIT_L(0); PG8_BAR; PG8_MMA(0, 0, At, B0); PG8_MMA(0, 1, At, B1); PG8_BAR; PG8_SCHED;
            PG8_LDA(At, 0, 1); PG8_STAGE(PG8_SB(0, 0), b2, voffB); PG8_STAGE(PG8_SB(0, 1), b2 + hstep, voffB); PG8_STAGE(PG8_SA(0, 0), a2, voffA);
            PG8_WAIT_V(8); PG8_WAIT_L(0); PG8_BAR; PG8_MMA(1, 0, At, B0); PG8_MMA(1, 1, At, B1); PG8_BAR; PG8_SCHED;
            PG8_LDB(B0, 1, 0); PG8_LDB(B1, 1, 1); PG8_SCHED; PG8_LDA(At, 1, 0); PG8_STAGE(PG8_SA(0, 1), a2 + hstep, voffA);
            PG8_WAIT_V(8); PG8_WAIT_L(0); PG8_BAR; PG8_MMA(0, 0, At, B0); PG8_MMA(0, 1, At, B1); PG8_BAR; PG8_SCHED;
            PG8_LDA(At, 1, 1); PG8_STAGE(PG8_SB(1, 0), b3, voffB); PG8_STAGE(PG8_SB(1, 1), b3 + hstep, voffB); PG8_STAGE(PG8_SA(1, 0), a3, voffA);
            PG8_WAIT_V(8); PG8_WAIT_L(0); PG8_BAR; PG8_MMA(1, 0, At, B0); PG8_MMA(1, 1, At, B1); PG8_BAR; PG8_SCHED;
            } else {
            PG8_LDB(B0, 0, 0); PG8_SCHED; PG8_LDA(At, 0, 0); PG8_STAGE(PG8_SA(1, 1), a1 + hstep, voffA);
            PG8_WAIT_L(8); PG8_BAR; PG8_WAIT_L(0); PG8_MMA(0, 0, At, B0); PG8_BAR; PG8_SCHED;
            PG8_LDB(B1, 0, 1); PG8_STAGE(PG8_SB(0, 0), b2, voffB);
            PG8_BAR; PG8_WAIT_L(0); PG8_MMA(0, 1, At, B1); PG8_BAR;
            PG8_LDA(At, 0, 1); PG8_STAGE(PG8_SA(0, 0), a2, voffA);
            PG8_BAR; PG8_WAIT_L(0); PG8_MMA(1, 0, At, B0); PG8_BAR; PG8_SCHED;
            PG8_STAGE(PG8_SB(0, 1), b2 + hstep, voffB);
            PG8_WAIT_V(6); PG8_BAR; PG8_MMA(1, 1, At, B1); PG8_BAR;
            PG8_LDB(B0, 1, 0); PG8_SCHED; PG8_LDA(At, 1, 0); PG8_STAGE(PG8_SA(0, 1), a2 + hstep, voffA);
            PG8_WAIT_L(8); PG8_BAR; PG8_WAIT_L(0); PG8_MMA(0, 0, At, B0); PG8_BAR; PG8_SCHED;
            PG8_LDB(B1, 1, 1); PG8_STAGE(PG8_SB(1, 0), b3, voffB);
            PG8_BAR; PG8_WAIT_L(0); PG8_MMA(0, 1, At, B1); PG8_BAR;
            PG8_LDA(At, 1, 1); PG8_STAGE(PG8_SA(1, 0), a3, voffA);
            PG8_BAR; PG8_WAIT_L(0); PG8_MMA(1, 0, At, B0); PG8_BAR; PG8_SCHED;
            PG8_STAGE(PG8_SB(1, 1), b3 + hstep, voffB);
            PG8_WAIT_V(6); PG8_BAR; PG8_MMA(1, 1, At, B1); PG8_BAR;
            }
        }
        if constexpr (ALIGN_EPI) { if (wr == 0) PG8_BAR; }
        if constexpr (!Epi::AFTER_DRAIN) { E(acc, cur, wr, wc, fr, fq); S.done(cur); }
        if (!has_next) break;
#pragma unroll
        for (int a = 0; a < 2; ++a)
#pragma unroll
            for (int b = 0; b < 2; ++b)
#pragma unroll
                for (int m = 0; m < 4; ++m)
#pragma unroll
                    for (int n = 0; n < 2; ++n) acc[a][b][m][n] = (f32x4){0.f, 0.f, 0.f, 0.f};
        cur = nxt; cA = nA; cB = nB; ++ui;
        if constexpr (ALIGN_EPI) { if (wr == 1) PG8_BAR; }
    }
    PG8_WAIT_V(0);
    if constexpr (!ALIGN_EPI) { if (wr == 0) PG8_BAR; }
    PG8_BAR;
    if constexpr (Epi::AFTER_DRAIN) { E.fused(acc, cur, wr, wc, fr, fq, lds, wid, lane); S.done(cur); }
#undef PG8_SA
#undef PG8_SB
#undef PG8_STAGE
#undef PG8_LDA
#undef PG8_LDB
#undef PG8_MMA
#undef PG8_WAIT_V
#undef PG8_WAIT_L
#undef PG8_BAR
#undef PG8_SCHED
}

__device__ __forceinline__ void store8(bf16_t* p, const f32x4& a, const f32x4& b) {
    u32x4 w; w.x = cvt_pk_bf16(a[0], a[1]); w.y = cvt_pk_bf16(a[2], a[3]); w.z = cvt_pk_bf16(b[0], b[1]); w.w = cvt_pk_bf16(b[2], b[3]);
    *(u32x4*)p = w;
}
struct EpiProj {
    static constexpr bool PERM = true, AFTER_DRAIN = false;
    bf16_t* qkv;
    const f32x2* rope;
    __device__ __forceinline__ void operator()(const Acc& acc, const Unit& u, int wr, int wc, int fr, int fq) const {
        const int kind = u.pn >> 1, halfsel = u.pn & 1;
        bf16_t* dst = qkv + (size_t)kind * (WS_SEG / 2);
        const int row0 = u.pm * BM + wr * 64 + fr;
        if (kind < 2) {
            const int hh = wc >> 1, i0 = 32 * (wc & 1) + 8 * fq;
            const float l2g = __builtin_log2f(1.0f - __builtin_exp2f(-5.0f - (float)(2 * halfsel + hh)));
            const int cbase = halfsel * 256 + hh * 128 + i0;
#pragma unroll
            for (int ai = 0; ai < 2; ++ai)
#pragma unroll
                for (int m = 0; m < 4; ++m) {
                    const int r = row0 + ai * HALF + m * 16, pos = r & (SEQ - 1), ic = pos & (CHUNK - 1);
                    const float sc = (kind == 0) ? __builtin_amdgcn_exp2f(l2g * (float)(ic + 1)) * 0.08838834764831845f : __builtin_amdgcn_exp2f(l2g * (float)(CHUNK - 1 - ic));
                    const f32x4* tp = (const f32x4*)(rope + (size_t)pos * 64 + i0);
                    const f32x4 t0 = tp[0], t1 = tp[1], t2 = tp[2], t3 = tp[3];
                    const f32x4 xa0 = acc[ai][0][m][0], xa1 = acc[ai][0][m][1], xb0 = acc[ai][1][m][0], xb1 = acc[ai][1][m][1];
                    f32x4 o10, o11, o20, o21;
                    o10[0] = (xa0[0] * t0[0] - xb0[0] * t0[1]) * sc; o20[0] = (xb0[0] * t0[0] + xa0[0] * t0[1]) * sc;
                    o10[1] = (xa0[1] * t0[2] - xb0[1] * t0[3]) * sc; o20[1] = (xb0[1] * t0[2] + xa0[1] * t0[3]) * sc;
                    o10[2] = (xa0[2] * t1[0] - xb0[2] * t1[1]) * sc; o20[2] = (xb0[2] * t1[0] + xa0[2] * t1[1]) * sc;
                    o10[3] = (xa0[3] * t1[2] - xb0[3] * t1[3]) * sc; o20[3] = (xb0[3] * t1[2] + xa0[3] * t1[3]) * sc;
                    o11[0] = (xa1[0] * t2[0] - xb1[0] * t2[1]) * sc; o21[0] = (xb1[0] * t2[0] + xa1[0] * t2[1]) * sc;
                    o11[1] = (xa1[1] * t2[2] - xb1[1] * t2[3]) * sc; o21[1] = (xb1[1] * t2[2] + xa1[1] * t2[3]) * sc;
                    o11[2] = (xa1[2] * t3[0] - xb1[2] * t3[1]) * sc; o21[2] = (xb1[2] * t3[0] + xa1[2] * t3[1]) * sc;
                    o11[3] = (xa1[3] * t3[2] - xb1[3] * t3[3]) * sc; o21[3] = (xb1[3] * t3[2] + xa1[3] * t3[3]) * sc;
                    bf16_t* rp = dst + (size_t)r * RW + cbase;
                    store8(rp, o10, o11); store8(rp + 64, o20, o21);
                }
        } else {
            const int cbase = halfsel * 256 + wc * 32 + 8 * fq;
#pragma unroll
            for (int ai = 0; ai < 2; ++ai)
#pragma unroll
                for (int m = 0; m < 4; ++m) {
                    bf16_t* rp = dst + (size_t)(row0 + ai * HALF + m * 16) * RW + cbase;
#pragma unroll
                    for (int bj = 0; bj < 2; ++bj) {
                        f32x4 v0 = acc[ai][bj][m][0], v1 = acc[ai][bj][m][1];
                        if (kind == 3) {
#pragma unroll
                            for (int j = 0; j < 4; ++j) { v0[j] = silu_(v0[j]); v1[j] = silu_(v1[j]); }
                        } else if (kind >= 4) {
#pragma unroll
                            for (int j = 0; j < 4; ++j) { v0[j] = gelu_(v0[j]); v1[j] = gelu_(v1[j]); }
                        }
                        store8(rp + bj * HALF, v0, v1);
                    }
                }
        }
    }
};
template <bool BASE_F32>
struct EpiResid {
    static constexpr bool PERM = true, AFTER_DRAIN = false;
    const void* base; bf16_t* outb; float* ss; LAS float* scr;
    __device__ __forceinline__ void operator()(const Acc& acc, const Unit& u, int wr, int wc, int fr, int fq) const {
        const int row0 = u.pm * BM + wr * 64 + fr, col0 = u.pn * BM + wc * 32 + 8 * fq;
#pragma unroll
        for (int ai = 0; ai < 2; ++ai)
#pragma unroll
            for (int m = 0; m < 4; ++m) {
                const int r = row0 + ai * HALF + m * 16; const size_t off = (size_t)r * DM + col0; float q = 0.f;
#pragma unroll
                for (int bj = 0; bj < 2; ++bj) {
                    f32x4 b0, b1;
                    if (BASE_F32) { b0 = *(const f32x4*)((const float*)base + off + bj * HALF); b1 = *(const f32x4*)((const float*)base + off + bj * HALF + 4); }
                    else { const u32x4 w = *(const u32x4*)((const bf16_t*)base + off + bj * HALF); b0 = (f32x4){bflo(w.x), bfhi(w.x), bflo(w.y), bfhi(w.y)}; b1 = (f32x4){bflo(w.z), bfhi(w.z), bflo(w.w), bfhi(w.w)}; }
                    const f32x4 v0 = acc[ai][bj][m][0] + b0, v1 = acc[ai][bj][m][1] + b1;
                    store8(outb + off + bj * HALF, v0, v1);
                    q += (v0[0] * v0[0] + v0[1] * v0[1]) + (v0[2] * v0[2] + v0[3] * v0[3]) + (v1[0] * v1[0] + v1[1] * v1[1]) + (v1[2] * v1[2] + v1[3] * v1[3]);
                }
                q += __shfl_xor(q, 16); q += __shfl_xor(q, 32);
                if (fq == 0) scr[(ai * HALF + wr * 64 + m * 16 + fr) * 4 + wc] = q;
            }
        asm volatile("s_waitcnt lgkmcnt(0)" ::: "memory"); __builtin_amdgcn_s_barrier(); asm volatile("" ::: "memory");
        if (threadIdx.x < 256) { const LAS f32x4* pp = (const LAS f32x4*)scr + threadIdx.x; const f32x4 v = *pp; ss[(size_t)u.pn * M + u.pm * BM + threadIdx.x] = (v[0] + v[1]) + (v[2] + v[3]); }
    }
};
__device__ __forceinline__ float row_rstd(const float* ss, int r) {
    const float s = (ss[r] + ss[(size_t)M + r]) + (ss[(size_t)2 * M + r] + ss[(size_t)3 * M + r]);
    return 1.0f / sqrtf(s * (1.0f / DM) + EPS);
}
struct EpiSwiglu {
    static constexpr bool PERM = true, AFTER_DRAIN = false;
    bf16_t* hid; const float* ss;
    __device__ __forceinline__ void operator()(const Acc& acc, const Unit& u, int wr, int wc, int fr, int fq) const {
        const int row0 = u.pm * BM + wr * 64 + fr, col0 = u.pn * HALF + wc * 32 + 8 * fq;
#pragma unroll
        for (int ai = 0; ai < 2; ++ai)
#pragma unroll
            for (int m = 0; m < 4; ++m) {
                const int r = row0 + ai * HALF + m * 16; const float rs = row_rstd(ss, r);
                f32x4 h0, h1;
#pragma unroll
                for (int j = 0; j < 4; ++j) { h0[j] = silu_(acc[ai][0][m][0][j] * rs) * (acc[ai][1][m][0][j] * rs); h1[j] = silu_(acc[ai][0][m][1][j] * rs) * (acc[ai][1][m][1][j] * rs); }
                store8(hid + (size_t)r * DFF + col0, h0, h1);
            }
    }
};

struct EpiNull {
    static constexpr bool PERM = true, AFTER_DRAIN = false;
    __device__ __forceinline__ void operator()(const Acc& acc, const Unit& u, int wr, int wc, int fr, int fq) const {
#pragma unroll
        for (int a = 0; a < 2; ++a)
#pragma unroll
            for (int b = 0; b < 2; ++b)
#pragma unroll
                for (int m = 0; m < 4; ++m) asm volatile("" :: "v"(acc[a][b][m][0]), "v"(acc[a][b][m][1]));
    }
};

__device__ __forceinline__ void transpose_item(const float* __restrict__ W, int ldw, int srccol0, int k0, const float* __restrict__ kscale, bf16_t* __restrict__ WT, int K, int dstrow0, LAS float* scr, int lane) {
#pragma unroll 8
    for (int i = 0; i < 32; ++i) { const int kk = 2 * i + (lane >> 5); float v = W[(size_t)(k0 + kk) * ldw + srccol0 + (lane & 31)]; if (kscale) v *= kscale[k0 + kk]; scr[kk * 33 + (lane & 31)] = v; }
    asm volatile("s_waitcnt lgkmcnt(0)" ::: "memory");
    const int c = lane & 7;
#pragma unroll
    for (int j = 0; j < 4; ++j) { const int n = (lane >> 3) + 8 * j; const LAS float* s = scr + (8 * c) * 33 + n;
        u32x4 o; o.x = cvt_pk_bf16(s[0 * 33], s[1 * 33]); o.y = cvt_pk_bf16(s[2 * 33], s[3 * 33]); o.z = cvt_pk_bf16(s[4 * 33], s[5 * 33]); o.w = cvt_pk_bf16(s[6 * 33], s[7 * 33]);
        *(u32x4*)(WT + (size_t)(dstrow0 + n) * K + k0 + 8 * c) = o; }
    asm volatile("s_waitcnt lgkmcnt(0)" ::: "memory");
}
__device__ __forceinline__ void sincos_d(double ang, float& s, float& c) {
    const double k = rint(ang * 0.63661977236758134308);
    const double r = fma(-k, 1.57079632679489661923, ang);
    const int q = (int)(((long long)k) & 3);
    const float x = (float)r, x2 = x * x;
    const float sp = x * (1.0f + x2 * (-1.6666667e-1f + x2 * (8.3333333e-3f + x2 * (-1.9841270e-4f + x2 * 2.7557319e-6f))));
    const float cp = 1.0f + x2 * (-0.5f + x2 * (4.1666667e-2f + x2 * (-1.3888889e-3f + x2 * (2.4801587e-5f + x2 * (-2.7557319e-7f)))));
    s = (q == 0) ? sp : (q == 1) ? cp : (q == 2) ? -sp : -cp;
    c = (q == 0) ? cp : (q == 1) ? -sp : (q == 2) ? -cp : sp;
}

struct Params {
    const float* in[14];
    float* out;
    unsigned char* ws;
    int ph_lo, ph_hi, use_cg, pad;
};

__device__ __forceinline__ void p0_prologue(const Params& p, LAS unsigned char* lds, int G, int bid) {
    const int tid = threadIdx.x, lane = tid & 63, wave = tid >> 6;
    const int gw = bid * 8 + wave, NGW = G * 8;
    LAS float* scr = (LAS float*)(lds + wave * 16384);
    const float* x = p.in[0]; const float* g1 = p.in[1]; const float* w_in = p.in[2];
    const float* w_s = p.in[6]; const float* w_out = p.in[8]; const float* g2 = p.in[9];
    const float* wg = p.in[10]; const float* wu = p.in[11]; const float* wd = p.in[12];
    bf16_t* W1 = (bf16_t*)(p.ws + WS_W1); bf16_t* W4 = (bf16_t*)(p.ws + WS_W4); bf16_t* W5 = (bf16_t*)(p.ws + WS_W5); bf16_t* W6 = (bf16_t*)(p.ws + WS_W6);
    constexpr int I1 = 16 * (NPROJ / 32), I4 = 16 * (DM / 32), I5 = 16 * (NFF2 / 32), I6 = (DFF / 64) * (DM / 32);
    for (int it = gw; it < I1 + I4 + I5 + I6; it += NGW) {
        int r = it;
        if (r < I1) { const int nb = r % (NPROJ / 32), kb = r / (NPROJ / 32), n0 = 32 * nb; int src = n0;
            if (n0 < 1024) { const int pn = n0 >> 8, pp = n0 & 255, bj = pp >> 7, rr = pp & 127, hh = rr >> 6, i = rr & 63; src = 256 * pn + 128 * hh + 64 * bj + i; }
            transpose_item(w_in, NPROJ, src, 64 * kb, nullptr, W1, DM, n0, scr, lane); continue; }
        r -= I1;
        if (r < I4) { const int nb = r % (DM / 32), kb = r / (DM / 32); transpose_item(w_out, DM, 32 * nb, 64 * kb, nullptr, W4, DM, 32 * nb, scr, lane); continue; }
        r -= I4;
        if (r < I5) { const int nb = r % (NFF2 / 32), kb = r / (NFF2 / 32), n0 = 32 * nb, pn = n0 >> 8, pp = n0 & 255, bj = pp >> 7, rr = pp & 127;
            transpose_item(bj ? wu : wg, DFF, 128 * pn + rr, 64 * kb, g2, W5, DM, n0, scr, lane); continue; }
        r -= I5;
        { const int nb = r % (DM / 32), kb = r / (DM / 32); transpose_item(wd, DM, 32 * nb, 64 * kb, nullptr, W6, DFF, 32 * nb, scr, lane); }
    }
    { bf16_t* WSb = (bf16_t*)(p.ws + WS_WS);
      for (int i = bid * 512 + tid; i < NG * GB * GB / 2; i += G * 512) { const int e = 2 * i, s = e & 127, t = (e >> 7) & 127; float a = w_s[e], b = w_s[e + 1]; if (t < 64 && s >= 64) { a = 0.f; b = 0.f; } ((unsigned*)WSb)[i] = cvt_pk_bf16(a, b); } }
    { f32x2* tab = (f32x2*)(p.ws + WS_ROPE);
      for (int i = bid * 512 + tid; i < SEQ * 64; i += G * 512) { const int pos = i >> 6, k = i & 63;
          const double inv = exp(-(double)k * (9.210340371976184 / 64.0));
          float s, c; sincos_d((double)pos * inv, s, c); tab[i] = (f32x2){c, s}; } }
    { bf16_t* XN = (bf16_t*)(p.ws + WS_XN);
      f32x4 gv[4];
#pragma unroll
      for (int j = 0; j < 4; ++j) gv[j] = ((const f32x4*)g1)[lane + 64 * j];
      for (int m = gw; m < M; m += NGW) {
          const f32x4* xr = (const f32x4*)(x + (size_t)m * DM) + lane; f32x4 v[4]; float s = 0.f;
#pragma unroll
          for (int j = 0; j < 4; ++j) { v[j] = xr[64 * j]; s += (v[j][0] * v[j][0] + v[j][1] * v[j][1]) + (v[j][2] * v[j][2] + v[j][3] * v[j][3]); }
          const float rstd = 1.0f / sqrtf(wave_sum(s) * (1.0f / DM) + EPS);
          u32x2* o = (u32x2*)(XN + (size_t)m * DM) + lane;
#pragma unroll
          for (int j = 0; j < 4; ++j) { u32x2 w; w.x = cvt_pk_bf16(v[j][0] * rstd * gv[j][0], v[j][1] * rstd * gv[j][1]); w.y = cvt_pk_bf16(v[j][2] * rstd * gv[j][2], v[j][3] * rstd * gv[j][3]); o[64 * j] = w; }
      } }
}

__device__ __forceinline__ void p2_gstats(const Params& p, int G, int bid) {
    const int tid = threadIdx.x, lane = tid & 63, wave = tid >> 6, gw = bid * 8 + wave, NGW = G * 8;
    const bf16_t* GV = (const bf16_t*)(p.ws + WS_Q + 5 * WS_SEG); f32x2* st = (f32x2*)(p.ws + WS_GST);
    for (int m = gw; m < M; m += NGW) {
        const u32x4 w = ((const u32x4*)(GV + (size_t)m * GW))[lane];
        float v[8] = {bflo(w.x), bfhi(w.x), bflo(w.y), bfhi(w.y), bflo(w.z), bfhi(w.z), bflo(w.w), bfhi(w.w)};
        float s = 0.f;
#pragma unroll
        for (int j = 0; j < 8; ++j) s += v[j];
        const float mean = wave_sum(s) * (1.0f / GW); float q = 0.f;
#pragma unroll
        for (int j = 0; j < 8; ++j) { const float d = v[j] - mean; q += d * d; }
        const float rstd = 1.0f / sqrtf(wave_sum(q) * (1.0f / GW) + EPS);
        if (lane == 0) st[m] = (f32x2){mean, rstd};
    }
}
__device__ __forceinline__ void p2_ret_naive(const Params& p, LAS unsigned char* lds, int G, int bid) {
    const int tid = threadIdx.x;
    const bf16_t* Q = (const bf16_t*)(p.ws + WS_Q); const bf16_t* Kb = (const bf16_t*)(p.ws + WS_Q + WS_SEG); const bf16_t* Vb = (const bf16_t*)(p.ws + WS_Q + 2 * WS_SEG);
    float* Y = (float*)(p.ws + WS_Y);
    LAS float* qs = (LAS float*)lds; LAS float* ks = qs + 64 * 129; LAS float* vs = ks + 64 * 129; LAS float* Ss = vs + 64 * 128;
    const int i = tid >> 3, eg = tid & 7;
    for (int item = bid; item < BATCH * NH * 64; item += G) {
        const int n = item & 63, bh = item >> 6, h = bh & 3, b = bh >> 2;
        const float l2g = log2f(1.0f - exp2f(-5.0f - (float)h));
        const size_t row0 = (size_t)b * SEQ + n * 64;
        __syncthreads();
        for (int idx = tid; idx < 64 * 128; idx += 512) { const int ii = idx >> 7, d = idx & 127; qs[ii * 129 + d] = bf2f(Q[(row0 + ii) * RW + h * HD + d]); }
        float acc[16];
#pragma unroll
        for (int e = 0; e < 16; ++e) acc[e] = 0.f;
        for (int mm = 0; mm <= n; ++mm) {
            const size_t rk0 = (size_t)b * SEQ + mm * 64;
            __syncthreads();
            for (int idx = tid; idx < 64 * 128; idx += 512) { const int jj = idx >> 7, d = idx & 127; ks[jj * 129 + d] = bf2f(Kb[(rk0 + jj) * RW + h * HD + d]); vs[jj * 128 + d] = bf2f(Vb[(rk0 + jj) * RW + h * HD + d]); }
            __syncthreads();
#pragma unroll 1
            for (int jj = 0; jj < 8; ++jj) { const int j = eg + 8 * jj; float dot = 0.f;
#pragma unroll 16
                for (int d = 0; d < 128; ++d) dot += qs[i * 129 + d] * ks[j * 129 + d];
                int dist = 64 * (n - mm) + i - j; dist = dist < 0 ? -dist : dist;
                Ss[i * 65 + j] = dot * exp2f(l2g * (float)(dist - (i + 1) - (63 - j))); }
            __syncthreads();
#pragma unroll 4
            for (int j = 0; j < 64; ++j) { const float s = Ss[i * 65 + j];
#pragma unroll
                for (int e = 0; e < 16; ++e) acc[e] += s * vs[j * 128 + e * 8 + eg]; }
        }
#pragma unroll
        for (int e = 0; e < 16; ++e) Y[(row0 + i) * RW + h * HD + e * 8 + eg] = acc[e];
    }
}


__device__ __forceinline__ void p2_gmlp(const Params& p, LAS unsigned char* lds, int G, int bid) {
    const int tid = threadIdx.x, lane = tid & 63, w = tid >> 6, l15 = lane & 15, l4 = lane >> 4;
    const bf16_t* GU = (const bf16_t*)(p.ws + WS_Q + 4 * WS_SEG); const bf16_t* GV = (const bf16_t*)(p.ws + WS_Q + 5 * WS_SEG);
    const bf16_t* WSb = (const bf16_t*)(p.ws + WS_WS); bf16_t* MIX = (bf16_t*)(p.ws + WS_MIX);
    const float* lng = p.in[4]; const float* lnb = p.in[5]; const float* b_s = p.in[7];
    for (int blk = bid; blk < M / GB; blk += G) {
        const size_t rb = (size_t)blk * GB;
        __syncthreads();
        {
            u32x4 raw[16];
#pragma unroll
            for (int r = 0; r < 16; ++r) raw[r] = *(const u32x4*)(GV + (rb + 16 * w + r) * GW + 8 * lane);
            const f32x4 lg0 = ((const f32x4*)lng)[2 * lane], lg1 = ((const f32x4*)lng)[2 * lane + 1], lb0 = ((const f32x4*)lnb)[2 * lane], lb1 = ((const f32x4*)lnb)[2 * lane + 1];
            const float lg[8] = {lg0[0], lg0[1], lg0[2], lg0[3], lg1[0], lg1[1], lg1[2], lg1[3]}, lb[8] = {lb0[0], lb0[1], lb0[2], lb0[3], lb1[0], lb1[1], lb1[2], lb1[3]};
#pragma unroll
            for (int kb = 0; kb < 2; ++kb) {
                float v[8][8];
#pragma unroll
                for (int rr = 0; rr < 8; ++rr) {
                    const u32x4 x = raw[8 * kb + rr];
                    v[rr][0] = bflo(x.x); v[rr][1] = bfhi(x.x); v[rr][2] = bflo(x.y); v[rr][3] = bfhi(x.y); v[rr][4] = bflo(x.z); v[rr][5] = bfhi(x.z); v[rr][6] = bflo(x.w); v[rr][7] = bfhi(x.w);
                    float sm = 0.f;
#pragma unroll
                    for (int cc = 0; cc < 8; ++cc) sm += v[rr][cc];
                    const float mean = wave_sum(sm) * (1.0f / GW); float q = 0.f;
#pragma unroll
                    for (int cc = 0; cc < 8; ++cc) { v[rr][cc] -= mean; q += v[rr][cc] * v[rr][cc]; }
                    const float rstd = 1.0f / sqrtf(wave_sum(q) * (1.0f / GW) + EPS);
#pragma unroll
                    for (int cc = 0; cc < 8; ++cc) v[rr][cc] = v[rr][cc] * rstd * lg[cc] + lb[cc];
                }
                const int g = l4, kbg = 2 * w + kb;
#pragma unroll
                for (int cc = 0; cc < 8; ++cc) {
                    u32x4 o; o.x = cvt_pk_bf16(v[0][cc], v[1][cc]); o.y = cvt_pk_bf16(v[2][cc], v[3][cc]); o.z = cvt_pk_bf16(v[4][cc], v[5][cc]); o.w = cvt_pk_bf16(v[6][cc], v[7][cc]);
                    const int ph = 8 * l15 + (cc ^ (l15 & 7));
                    *(LAS u32x4*)(lds + (((g * 16 + kbg) * 128 + ph) << 4)) = o;
                }
            }
        }
        __syncthreads();
        {
            const int g = w >> 1, chh = w & 1;
            f32x4 acc[2][2][8];
#pragma unroll
            for (int a = 0; a < 2; ++a)
#pragma unroll
                for (int n = 0; n < 2; ++n)
#pragma unroll
                    for (int ti = 0; ti < 8; ++ti) acc[a][n][ti] = (f32x4){0.f, 0.f, 0.f, 0.f};
            const bf16_t* wp = WSb + ((size_t)(g * 128 + l15) * 128 + 8 * l4);
#pragma unroll 1
            for (int ks = 0; ks < 4; ++ks) {
                bf16x8 X[2][2];
#pragma unroll
                for (int a = 0; a < 2; ++a)
#pragma unroll
                    for (int n = 0; n < 2; ++n) { const int c = 64 * chh + 32 * a + 8 * (l15 >> 2) + 4 * n + (l15 & 3), ph = c ^ ((c >> 3) & 7);
                        X[a][n] = *(const LAS bf16x8*)(lds + (((g * 16 + 4 * ks + l4) * 128 + ph) << 4)); }
#pragma unroll
                for (int ti = 0; ti < 8; ++ti) {
                    if (ti < 4 && ks >= 2) continue;
                    const bf16x8 Y = *(const bf16x8*)(wp + (size_t)(16 * ti) * 128 + 32 * ks);
#pragma unroll
                    for (int a = 0; a < 2; ++a)
#pragma unroll
                        for (int n = 0; n < 2; ++n) acc[a][n][ti] = __builtin_amdgcn_mfma_f32_16x16x32_bf16(X[a][n], Y, acc[a][n][ti], 0, 0, 0);
                }
            }
#pragma unroll
            for (int ti = 0; ti < 8; ++ti) {
                const int t = 16 * ti + l15; const float bsv = b_s[g * 128 + t];
#pragma unroll
                for (int a = 0; a < 2; ++a) {
                    const int ch0 = g * 128 + 64 * chh + 32 * a + 8 * l4;
                    const u32x4 gu = *(const u32x4*)(GU + (rb + t) * GW + ch0);
                    f32x4 o0, o1;
                    o0[0] = bflo(gu.x) * (acc[a][0][ti][0] + bsv); o0[1] = bfhi(gu.x) * (acc[a][0][ti][1] + bsv); o0[2] = bflo(gu.y) * (acc[a][0][ti][2] + bsv); o0[3] = bfhi(gu.y) * (acc[a][0][ti][3] + bsv);
                    o1[0] = bflo(gu.z) * (acc[a][1][ti][0] + bsv); o1[1] = bfhi(gu.z) * (acc[a][1][ti][1] + bsv); o1[2] = bflo(gu.w) * (acc[a][1][ti][2] + bsv); o1[3] = bfhi(gu.w) * (acc[a][1][ti][3] + bsv);
                    store8(MIX + (rb + t) * DM + RW + ch0, o0, o1);
                }
            }
        }
    }
}


typedef float f32x16 __attribute__((ext_vector_type(16)));
typedef short s16x4 __attribute__((ext_vector_type(4)));
#define MFMA32(a, b, c) __builtin_amdgcn_mfma_f32_32x32x16_bf16((a), (b), (c), 0, 0, 0)
constexpr size_t WS_T = 368 * MiB;
__device__ __forceinline__ unsigned off_a(unsigned row, unsigned ch) { return 2048u * (row >> 3) + 512u * (ch >> 2) + 64u * (row & 7u) + 16u * ((ch & 3u) ^ ((row >> 2) & 3u)); }
__device__ __forceinline__ int crow(int reg, int h) { return (reg & 3) + 8 * (reg >> 2) + 4 * h; }
template <int S> __device__ __forceinline__ bf16x8 pack8(const f32x16& x) {
    u32x4 p; p.x = cvt_pk_bf16(x[8 * S], x[8 * S + 1]); p.y = cvt_pk_bf16(x[8 * S + 2], x[8 * S + 3]); p.z = cvt_pk_bf16(x[8 * S + 4], x[8 * S + 5]); p.w = cvt_pk_bf16(x[8 * S + 6], x[8 * S + 7]);
    return __builtin_bit_cast(bf16x8, p);
}
__device__ __forceinline__ unsigned tr_lane_base(int lane, int t) {
    const unsigned h = lane >> 5, blk = (lane >> 4) & 1, q = (lane & 15) >> 2, p = lane & 3;
    return off_a(8u * t + 4u * h + q, 2u * blk + (p >> 1)) + 8u * (p & 1);
}
template <int COFF> __device__ __forceinline__ void tr_frags64(bf16x8 (&f)[4], unsigned b0, unsigned b1) {
    s16x4 x0, x1, x2, x3, x4, x5, x6, x7;
    asm volatile("ds_read_b64_tr_b16 %0, %8 offset:%10\n\tds_read_b64_tr_b16 %1, %9 offset:%10\n\tds_read_b64_tr_b16 %2, %8 offset:%11\n\tds_read_b64_tr_b16 %3, %9 offset:%11\n\t"
                 "ds_read_b64_tr_b16 %4, %8 offset:%12\n\tds_read_b64_tr_b16 %5, %9 offset:%12\n\tds_read_b64_tr_b16 %6, %8 offset:%13\n\tds_read_b64_tr_b16 %7, %9 offset:%13\n\ts_waitcnt lgkmcnt(0)"
                 : "=&v"(x0), "=&v"(x1), "=&v"(x2), "=&v"(x3), "=&v"(x4), "=&v"(x5), "=&v"(x6), "=&v"(x7)
                 : "v"(b0), "v"(b1), "i"(COFF), "i"(COFF + 4096), "i"(COFF + 8192), "i"(COFF + 12288) : "memory");
    f[0] = __builtin_shufflevector(x0, x1, 0, 1, 2, 3, 4, 5, 6, 7); f[1] = __builtin_shufflevector(x2, x3, 0, 1, 2, 3, 4, 5, 6, 7);
    f[2] = __builtin_shufflevector(x4, x5, 0, 1, 2, 3, 4, 5, 6, 7); f[3] = __builtin_shufflevector(x6, x7, 0, 1, 2, 3, 4, 5, 6, 7);
}

__device__ __forceinline__ void p2_tseg(const Params& p, LAS unsigned char* lds, int G, int bid) {
    const int tid = threadIdx.x, lane = tid & 63, w = tid >> 6, et = w & 3, dp = w >> 2;
    const bf16_t* Kb = (const bf16_t*)(p.ws + WS_Q + WS_SEG); const bf16_t* Vb = (const bf16_t*)(p.ws + WS_Q + 2 * WS_SEG);
    float* Tb = (float*)(p.ws + WS_T);
    const unsigned lbase = (unsigned)(size_t)lds;
    const unsigned tb0 = tr_lane_base(lane, 0), tb1 = tr_lane_base(lane, 1);
    for (int item = bid; item < BATCH * NH * 8; item += G) {
        const int seg = item & 7, bh = item >> 3, h = bh & 3, b = bh >> 2;
        const float cd = exp2f(64.0f * log2f(1.0f - exp2f(-5.0f - (float)h)));
        const size_t row0 = (size_t)b * SEQ + seg * 512;
        f32x16 T0, T1;
#pragma unroll
        for (int i = 0; i < 16; ++i) { T0[i] = 0.f; T1[i] = 0.f; }
        u32x4 stg[8];
#define TS_LOAD(st) do { _Pragma("unroll") for (int u = 0; u < 4; ++u) { const int c = tid + 512 * u, rr = c >> 4, ch = c & 15; const size_t go = (row0 + 128 * (st) + rr) * RW + h * HD + ch * 8; \
            stg[u] = *(const u32x4*)(Kb + go); stg[4 + u] = *(const u32x4*)(Vb + go); } } while (0)
#define TS_WRITE(buf) do { _Pragma("unroll") for (int u = 0; u < 4; ++u) { const int c = tid + 512 * u, rr = c >> 4, ch = c & 15; const unsigned o = (buf) * 65536u + (rr >> 6) * 16384u + off_a(rr & 63, ch); \
            *(LAS u32x4*)(lds + o) = stg[u]; *(LAS u32x4*)(lds + 32768u + o) = stg[4 + u]; } } while (0)
        __syncthreads();
        TS_LOAD(0); TS_WRITE(0);
#pragma unroll 1
        for (int st = 0; st < 4; ++st) {
            __syncthreads();
            if (st < 3) TS_LOAD(st + 1);
            const unsigned kb = lbase + (st & 1) * 65536u, vb = kb + 32768u + 512u * et;
#pragma unroll
            for (int cc = 0; cc < 2; ++cc) {
                bf16x8 vf[4], kf[4];
                tr_frags64<0>(vf, vb + cc * 16384u + tb0, vb + cc * 16384u + tb1);
                T0 = T0 * cd; T1 = T1 * cd;
                const unsigned k0 = kb + cc * 16384u + 1024u * dp;
                tr_frags64<0>(kf, k0 + tb0, k0 + tb1);
#pragma unroll
                for (int f = 0; f < 4; ++f) T0 = MFMA32(kf[f], vf[f], T0);
                tr_frags64<512>(kf, k0 + tb0, k0 + tb1);
#pragma unroll
                for (int f = 0; f < 4; ++f) T1 = MFMA32(kf[f], vf[f], T1);
            }
            if (st < 3) TS_WRITE((st + 1) & 1);
        }
#undef TS_LOAD
#undef TS_WRITE
        f32x4* o0 = (f32x4*)(Tb + ((size_t)(item * 16 + (2 * dp) * 4 + et) * 64 + lane) * 16);
        f32x4* o1 = (f32x4*)(Tb + ((size_t)(item * 16 + (2 * dp + 1) * 4 + et) * 64 + lane) * 16);
#pragma unroll
        for (int i = 0; i < 4; ++i) { o0[i] = (f32x4){T0[4 * i], T0[4 * i + 1], T0[4 * i + 2], T0[4 * i + 3]}; o1[i] = (f32x4){T1[4 * i], T1[4 * i + 1], T1[4 * i + 2], T1[4 * i + 3]}; }
    }
}

__device__ __forceinline__ void p3_retention(const Params& p, LAS unsigned char* lds, int G, int bid) {
    const int tid = threadIdx.x, lane = tid & 63, w = tid >> 6, et = w & 3, it = w >> 2, r = lane & 31, hh = lane >> 5;
    const bf16_t* Qg = (const bf16_t*)(p.ws + WS_Q); const bf16_t* Kg = (const bf16_t*)(p.ws + WS_Q + WS_SEG); const bf16_t* Vg = (const bf16_t*)(p.ws + WS_Q + 2 * WS_SEG);
    const bf16_t* SG = (const bf16_t*)(p.ws + WS_Q + 3 * WS_SEG); bf16_t* MIX = (bf16_t*)(p.ws + WS_MIX);
    const float* Tb = (const float*)(p.ws + WS_T); const float* gn = p.in[3];
    const unsigned lbase = (unsigned)(size_t)lds;
    constexpr unsigned OT_OFF = 98304u, OT_LD = 132u;
    const unsigned tb0 = tr_lane_base(lane, 0), tb1 = tr_lane_base(lane, 1);
    const unsigned rr0 = off_a(r, hh), rr1 = off_a(r, 2 + hh);
    const int ri = tid >> 3, part = tid & 7;
    for (int item = bid; item < BATCH * NH * 8; item += G) {
        const int seg = item & 7, bh = item >> 3, h = bh & 3, b = bh >> 2;
        const float l2g = log2f(1.0f - exp2f(-5.0f - (float)h)), cd = exp2f(64.0f * l2g);
        const size_t row0 = (size_t)b * SEQ + seg * 512;
        f32x16 St[4];
#pragma unroll
        for (int dt = 0; dt < 4; ++dt)
#pragma unroll
            for (int i = 0; i < 16; ++i) St[dt][i] = 0.f;
#pragma unroll 1
        for (int sp = 0; sp < seg; ++sp) {
            const float wgt = exp2f(512.0f * l2g * (float)(seg - 1 - sp));
#pragma unroll
            for (int dt = 0; dt < 4; ++dt) {
                const f32x4* tp = (const f32x4*)(Tb + ((size_t)((bh * 8 + sp) * 16 + dt * 4 + et) * 64 + lane) * 16);
#pragma unroll
                for (int i = 0; i < 4; ++i) { const f32x4 t = tp[i]; St[dt][4 * i] += wgt * t[0]; St[dt][4 * i + 1] += wgt * t[1]; St[dt][4 * i + 2] += wgt * t[2]; St[dt][4 * i + 3] += wgt * t[3]; }
            }
        }
        u32x4 stg[6], sgr[2];
#define RT_LOAD(c) do { _Pragma("unroll") for (int u = 0; u < 2; ++u) { const int cq = tid + 512 * u, rr = cq >> 4, ch = cq & 15; const size_t go = (row0 + 64 * (c) + rr) * RW + h * HD + ch * 8; \
            stg[u] = *(const u32x4*)(Qg + go); stg[2 + u] = *(const u32x4*)(Kg + go); stg[4 + u] = *(const u32x4*)(Vg + go); } } while (0)
#define RT_WRITE(buf) do { _Pragma("unroll") for (int u = 0; u < 2; ++u) { const int cq = tid + 512 * u, rr = cq >> 4, ch = cq & 15; const unsigned o = (buf) * 49152u + off_a(rr, ch); \
            *(LAS u32x4*)(lds + o) = stg[u]; *(LAS u32x4*)(lds + 16384u + o) = stg[2 + u]; *(LAS u32x4*)(lds + 32768u + o) = stg[4 + u]; } } while (0)
        __syncthreads();
        RT_LOAD(0); RT_WRITE(0);
#pragma unroll 1
        for (int c = 0; c < 8; ++c) {
            __syncthreads();
            if (c < 7) RT_LOAD(c + 1);
            { const size_t so = (row0 + 64 * c + ri) * RW + h * HD + 16 * part; sgr[0] = *(const u32x4*)(SG + so); sgr[1] = *(const u32x4*)(SG + so + 8); }
            const LAS unsigned char* Qb = lds + (c & 1) * 49152u + 8192u * it;
            const LAS unsigned char* Kb = lds + (c & 1) * 49152u + 16384u;
            const unsigned kbu = lbase + (c & 1) * 49152u + 16384u, vbu = kbu + 16384u + 512u * et;
            f32x16 X0, X1, O;
#pragma unroll
            for (int i = 0; i < 16; ++i) { X0[i] = 0.f; X1[i] = 0.f; O[i] = 0.f; }
#pragma unroll
            for (int ks = 0; ks < 8; ++ks) {
                const unsigned ro = ((ks & 1) ? rr1 : rr0) + 512u * (ks >> 1);
                const bf16x8 bq = *(const LAS bf16x8*)(Qb + ro);
                const bf16x8 a0 = *(const LAS bf16x8*)(Kb + ro), a1 = *(const LAS bf16x8*)(Kb + 8192u + ro);
                X0 = MFMA32(a0, bq, X0); X1 = MFMA32(a1, bq, X1);
                if (ks & 1) __builtin_amdgcn_sched_barrier(0);
            }
            { float ebase = __builtin_amdgcn_exp2f(2.0f * l2g * (float)(4 * hh - (32 * it + r)));
              asm volatile("" : "+v"(ebase));
              const float g2 = __builtin_amdgcn_exp2f(2.0f * l2g), g2_8 = __builtin_amdgcn_exp2f(16.0f * l2g), g2_32 = __builtin_amdgcn_exp2f(64.0f * l2g), cinv = __builtin_amdgcn_exp2f(-64.0f * l2g);
              float e0 = ebase, e1 = ebase * g2_32;
#pragma unroll
              for (int qd = 0; qd < 4; ++qd) {
                  float a = e0, bq2 = e1;
#pragma unroll
                  for (int k = 0; k < 4; ++k) { X0[4 * qd + k] *= cinv * fminf(1.0f, a); X1[4 * qd + k] *= cinv * fminf(1.0f, bq2); a *= g2; bq2 *= g2; }
                  e0 *= g2_8; e1 *= g2_8;
              } }
            const bf16x8 P00 = pack8<0>(X0), P01 = pack8<1>(X0), P10 = pack8<0>(X1), P11 = pack8<1>(X1);
            __builtin_amdgcn_sched_barrier(0);
            bf16x8 vf[4];
            tr_frags64<0>(vf, vbu + tb0, vbu + tb1);
            O = MFMA32(vf[0], P00, O); O = MFMA32(vf[1], P01, O); O = MFMA32(vf[2], P10, O); O = MFMA32(vf[3], P11, O);
            __builtin_amdgcn_sched_barrier(0);
#pragma unroll
            for (int dt = 0; dt < 4; ++dt) {
                const s16x4 l0 = *(const LAS s16x4*)(Qb + off_a(r, 4 * dt + 0) + 8 * hh), h0 = *(const LAS s16x4*)(Qb + off_a(r, 4 * dt + 1) + 8 * hh);
                const s16x4 l1 = *(const LAS s16x4*)(Qb + off_a(r, 4 * dt + 2) + 8 * hh), h1 = *(const LAS s16x4*)(Qb + off_a(r, 4 * dt + 3) + 8 * hh);
                const bf16x8 q0 = __builtin_shufflevector(l0, h0, 0, 1, 2, 3, 4, 5, 6, 7), q1 = __builtin_shufflevector(l1, h1, 0, 1, 2, 3, 4, 5, 6, 7);
                O = MFMA32(pack8<0>(St[dt]), q0, O); O = MFMA32(pack8<1>(St[dt]), q1, O);
                if (dt & 1) __builtin_amdgcn_sched_barrier(0);
            }
            {
                bf16x8 kf[4];
                tr_frags64<0>(kf, kbu + tb0, kbu + tb1);
                St[0] = St[0] * cd;
#pragma unroll
                for (int f = 0; f < 4; ++f) St[0] = MFMA32(kf[f], vf[f], St[0]);
                tr_frags64<512>(kf, kbu + tb0, kbu + tb1);
                St[1] = St[1] * cd;
#pragma unroll
                for (int f = 0; f < 4; ++f) St[1] = MFMA32(kf[f], vf[f], St[1]);
                tr_frags64<1024>(kf, kbu + tb0, kbu + tb1);
                St[2] = St[2] * cd;
#pragma unroll
                for (int f = 0; f < 4; ++f) St[2] = MFMA32(kf[f], vf[f], St[2]);
                tr_frags64<1536>(kf, kbu + tb0, kbu + tb1);
                St[3] = St[3] * cd;
#pragma unroll
                for (int f = 0; f < 4; ++f) St[3] = MFMA32(kf[f], vf[f], St[3]);
            }
            __builtin_amdgcn_sched_barrier(0);
            { LAS float* ot = (LAS float*)(lds + OT_OFF) + (32 * it + r) * OT_LD + 32 * et + 4 * hh;
#pragma unroll
              for (int qd = 0; qd < 4; ++qd) *(LAS f32x4*)(ot + 8 * qd) = (f32x4){O[4 * qd], O[4 * qd + 1], O[4 * qd + 2], O[4 * qd + 3]}; }
            __syncthreads();
            { const LAS f32x4* op = (const LAS f32x4*)((const LAS float*)(lds + OT_OFF) + ri * OT_LD + 16 * part);
              f32x4 o[4]; float sm = 0.f;
#pragma unroll
              for (int u = 0; u < 4; ++u) { o[u] = op[u]; sm += (o[u][0] + o[u][1]) + (o[u][2] + o[u][3]); }
              sm += __shfl_xor(sm, 1); sm += __shfl_xor(sm, 2); sm += __shfl_xor(sm, 4);
              const float mean = sm * (1.0f / HD); float q = 0.f;
#pragma unroll
              for (int u = 0; u < 4; ++u) { o[u] = o[u] - mean; q += (o[u][0] * o[u][0] + o[u][1] * o[u][1]) + (o[u][2] * o[u][2] + o[u][3] * o[u][3]); }
              q += __shfl_xor(q, 1); q += __shfl_xor(q, 2); q += __shfl_xor(q, 4);
              const float rstd = 1.0f / sqrtf(q * (1.0f / HD) + EPS);
              const f32x4* gp = (const f32x4*)(gn + h * HD + 16 * part);
              const unsigned sw[8] = {sgr[0].x, sgr[0].y, sgr[0].z, sgr[0].w, sgr[1].x, sgr[1].y, sgr[1].z, sgr[1].w};
#pragma unroll
              for (int u = 0; u < 4; ++u) { const f32x4 g4 = gp[u];
                  o[u][0] = o[u][0] * rstd * g4[0] * bflo(sw[2 * u]); o[u][1] = o[u][1] * rstd * g4[1] * bfhi(sw[2 * u]);
                  o[u][2] = o[u][2] * rstd * g4[2] * bflo(sw[2 * u + 1]); o[u][3] = o[u][3] * rstd * g4[3] * bfhi(sw[2 * u + 1]); }
              bf16_t* mp = MIX + (row0 + 64 * c + ri) * DM + h * HD + 16 * part;
              store8(mp, o[0], o[1]); store8(mp + 8, o[2], o[3]); }
            if (c < 7) RT_WRITE((c + 1) & 1);
        }
#undef RT_LOAD
#undef RT_WRITE
    }
}

__device__ __forceinline__ void p3_gn_gate(const Params& p, int G, int bid) {
    const int tid = threadIdx.x, lane = tid & 63, wave = tid >> 6, gw = bid * 8 + wave, NGW = G * 8;
    const float* Y = (const float*)(p.ws + WS_Y); const bf16_t* SG = (const bf16_t*)(p.ws + WS_Q + 3 * WS_SEG); bf16_t* MIX = (bf16_t*)(p.ws + WS_MIX);
    const float* gn = p.in[3];
    const f32x4 g0 = ((const f32x4*)gn)[2 * lane], g1 = ((const f32x4*)gn)[2 * lane + 1];
    for (int m = gw; m < M; m += NGW) {
        const f32x4 a = ((const f32x4*)(Y + (size_t)m * RW))[2 * lane], b = ((const f32x4*)(Y + (size_t)m * RW))[2 * lane + 1];
        float s = (a[0] + a[1]) + (a[2] + a[3]) + (b[0] + b[1]) + (b[2] + b[3]);
        s += __shfl_xor(s, 1); s += __shfl_xor(s, 2); s += __shfl_xor(s, 4); s += __shfl_xor(s, 8);
        const float mean = s * (1.0f / HD);
        const f32x4 da = a - mean, db = b - mean;
        float q = (da[0] * da[0] + da[1] * da[1]) + (da[2] * da[2] + da[3] * da[3]) + (db[0] * db[0] + db[1] * db[1]) + (db[2] * db[2] + db[3] * db[3]);
        q += __shfl_xor(q, 1); q += __shfl_xor(q, 2); q += __shfl_xor(q, 4); q += __shfl_xor(q, 8);
        const float rstd = 1.0f / sqrtf(q * (1.0f / HD) + EPS);
        const u32x4 sg = ((const u32x4*)(SG + (size_t)m * RW))[lane];
        f32x4 o0, o1;
        o0[0] = da[0] * rstd * g0[0] * bflo(sg.x); o0[1] = da[1] * rstd * g0[1] * bfhi(sg.x); o0[2] = da[2] * rstd * g0[2] * bflo(sg.y); o0[3] = da[3] * rstd * g0[3] * bfhi(sg.y);
        o1[0] = db[0] * rstd * g1[0] * bflo(sg.z); o1[1] = db[1] * rstd * g1[1] * bfhi(sg.z); o1[2] = db[2] * rstd * g1[2] * bflo(sg.w); o1[3] = db[3] * rstd * g1[3] * bfhi(sg.w);
        store8(MIX + (size_t)m * DM + 8 * lane, o0, o1);
    }
}
__device__ __forceinline__ void p3_gmlp_naive(const Params& p, LAS unsigned char* lds, int G, int bid) {
    const int tid = threadIdx.x;
    const bf16_t* GU = (const bf16_t*)(p.ws + WS_Q + 4 * WS_SEG); const bf16_t* GV = (const bf16_t*)(p.ws + WS_Q + 5 * WS_SEG);
    const f32x2* st = (const f32x2*)(p.ws + WS_GST); bf16_t* MIX = (bf16_t*)(p.ws + WS_MIX);
    const float* lng = p.in[4]; const float* lnb = p.in[5]; const float* w_s = p.in[6]; const float* b_s = p.in[7];
    LAS float* vn = (LAS float*)lds; LAS float* wl = vn + 128 * 128;
    const int c = tid & 127, tg = tid >> 7;
    for (int item = bid; item < (M / GB) * NG; item += G) {
        const int g = item & 3, blk = item >> 2; const size_t rb = (size_t)blk * GB; const int ch = g * 128 + c;
        __syncthreads();
        const float lg = lng[ch], lb = lnb[ch];
        for (int s = tg; s < 128; s += 4) { const f32x2 ms = st[rb + s]; vn[s * 128 + c] = (bf2f(GV[(rb + s) * GW + ch]) - ms[0]) * ms[1] * lg + lb; }
        for (int idx = tid; idx < 128 * 128; idx += 512) wl[idx] = w_s[(size_t)g * 128 * 128 + idx];
        __syncthreads();
        for (int tt = 0; tt < 32; ++tt) { const int t = tg * 32 + tt; const int smax = (t < 64) ? 64 : 128; float sum = 0.f;
            for (int s = 0; s < smax; ++s) sum += wl[t * 128 + s] * vn[s * 128 + c];
            const float mixed = sum + b_s[g * 128 + t];
            const float o = bf2f(GU[(rb + t) * GW + ch]) * mixed;
            MIX[(rb + t) * DM + RW + ch] = (bf16_t)(cvt_pk_bf16(o, 0.f) & 0xffffu); }
    }
}

__device__ __forceinline__ void p7_final(const Params& p, int G, int bid, float* dst) {
    const int tid = threadIdx.x, lane = tid & 63, wave = tid >> 6, gw = bid * 8 + wave, NGW = G * 8;
    const float* ss = (const float*)(p.ws + WS_SS2); const float* fg = p.in[13]; const bf16_t* X2 = (const bf16_t*)(p.ws + WS_MIX);
    f32x4 gv[4];
#pragma unroll
    for (int j = 0; j < 4; ++j) gv[j] = ((const f32x4*)fg)[2 * lane + 128 * (j >> 1) + (j & 1)];
    for (int m = gw; m < M; m += NGW) {
        const float rs = row_rstd(ss, m);
        const u32x4* xr = (const u32x4*)(X2 + (size_t)m * DM) + lane; f32x4* xo = (f32x4*)(dst + (size_t)m * DM) + 2 * lane;
#pragma unroll
        for (int hlf = 0; hlf < 2; ++hlf) { const u32x4 w = xr[64 * hlf];
            const f32x4 a = (f32x4){bflo(w.x), bfhi(w.x), bflo(w.y), bfhi(w.y)} * rs * gv[2 * hlf], b = (f32x4){bflo(w.z), bfhi(w.z), bflo(w.w), bfhi(w.w)} * rs * gv[2 * hlf + 1];
            xo[128 * hlf] = a; xo[128 * hlf + 1] = b; }
    }
}

#define XB_TMO      128
#define XB_XCNT(j)  (256  + 64 * (j))
#define XB_XSUB(j)  (1280 + 64 * (j))
#define XB_XGEN(j)  (2304 + 64 * (j))
#define XB_TOP      3328
#define XB_TOPGEN   3392
#define XCD_BAR_WORDS 3456
#define XB_SPIN_CAP (1u << 18)

__device__ __forceinline__ unsigned xb_ld(unsigned* p)              { return __hip_atomic_load(p, __ATOMIC_RELAXED, __HIP_MEMORY_SCOPE_AGENT); }
__device__ __forceinline__ unsigned xb_add(unsigned* p, unsigned v) { return __hip_atomic_fetch_add(p, v, __ATOMIC_RELAXED, __HIP_MEMORY_SCOPE_AGENT); }
__device__ __forceinline__ unsigned xb_xcc_id() { return (unsigned)__builtin_amdgcn_s_getreg((3 << 11) | 20) & 0xFu; }
#define XB_SPIN(cond, bar) do { unsigned _sp = 0; while (cond) { __builtin_amdgcn_s_sleep(1); \
    if ((++_sp & 255u) == 0u) { if (xb_ld(&(bar)[XB_TMO])) break; if (_sp > XB_SPIN_CAP) { atomicAdd(&(bar)[XB_TMO], 1u); break; } } } } while (0)

struct XcdBarrier {
    unsigned* bar; unsigned x;
    volatile LAS unsigned* st;
};

__device__ __forceinline__ XcdBarrier xcd_barrier_post(unsigned* bar, volatile LAS unsigned* st) {
    XcdBarrier b; b.bar = bar; b.x = xb_xcc_id(); b.st = st;
    if (threadIdx.x == 0) (void)xb_add(&bar[XB_XCNT(b.x)], 1u);
    return b;
}
__device__ __forceinline__ void xcd_barrier_complete(unsigned* bar, unsigned x, unsigned& nloc, unsigned& nx) {
    const unsigned G = gridDim.x * gridDim.y * gridDim.z;
    unsigned sum, cnt, mine, sp = 0u;
    for (;;) {
        sum = 0u; cnt = 0u; mine = 0u;
#pragma unroll
        for (unsigned j = 0; j < 16; ++j) { const unsigned c = xb_ld(&bar[XB_XCNT(j)]); sum += c; cnt += (c > 0u) ? 1u : 0u; mine = (j == x) ? c : mine; }
        if (sum == G) break;
        __builtin_amdgcn_s_sleep(1);
        if ((++sp & 255u) == 0u) { if (xb_ld(&bar[XB_TMO])) break; if (sp > XB_SPIN_CAP) { atomicAdd(&bar[XB_TMO], 1u); break; } }
    }
    nloc = mine > 0u ? mine : 1u; nx = cnt > 0u ? cnt : 1u;
}

__device__ __forceinline__ void xcd_barrier(const XcdBarrier& b) {
    asm volatile("s_waitcnt vmcnt(0)" ::: "memory");
    __syncthreads();
    if (threadIdx.x == 0) {
        unsigned* bar = b.bar;
        __builtin_amdgcn_s_waitcnt(0);
        unsigned nloc = b.st[0], nx = b.st[1];
        if (nloc == 0u) { xcd_barrier_complete(bar, b.x, nloc, nx); b.st[0] = nloc; b.st[1] = nx; }
        const unsigned old = xb_add(&bar[XB_XSUB(b.x)], 1u);
        const unsigned gen = old / nloc;
        if (old + 1u == (gen + 1u) * nloc) {
            __builtin_amdgcn_fence(__ATOMIC_RELEASE, "agent");
            asm volatile("s_waitcnt vmcnt(0)" ::: "memory");
            const unsigned og = xb_add(&bar[XB_TOP], 1u);
            const unsigned tg = og / nx;
            if (og + 1u == (tg + 1u) * nx) xb_add(&bar[XB_TOPGEN], 1u);
            else XB_SPIN(xb_ld(&bar[XB_TOPGEN]) == tg, bar);
            __builtin_amdgcn_fence(__ATOMIC_ACQUIRE, "agent");
            xb_add(&bar[XB_XGEN(b.x)], 1u);
            asm volatile("s_waitcnt vmcnt(0)" ::: "memory");
        } else {
            XB_SPIN(xb_ld(&bar[XB_XGEN(b.x)]) == gen, bar);
            __builtin_amdgcn_fence(__ATOMIC_ACQUIRE, "agent");
            asm volatile("s_waitcnt vmcnt(0)" ::: "memory");
        }
    }
    __syncthreads();
}

__global__ void __launch_bounds__(512, 2) fwd_kernel(Params p) {
    extern __shared__ __attribute__((aligned(16))) unsigned char lds_raw[];
    LAS unsigned char* lds = (LAS unsigned char*)lds_raw;
    const int G = gridDim.x, bid = blockIdx.x;
    unsigned char* ws = p.ws;
    const int lo = p.ph_lo, hi = p.ph_hi;
    { volatile LAS unsigned* st = (volatile LAS unsigned*)(lds + LDS_BYTES - 64); if (threadIdx.x < 2) st[threadIdx.x] = 0u; __syncthreads(); }
    const XcdBarrier bar = xcd_barrier_post((unsigned*)ws, (volatile LAS unsigned*)(lds + LDS_BYTES - 64));
#define IN(k) (lo <= (k) && (k) < hi)
#define SEAM(k) do { if (IN(k) && IN((k) + 1)) { if (p.use_cg) cg::this_grid().sync(); else xcd_barrier(bar); } } while (0)
#ifndef PROBE_REPEAT
#define PROBE_REPEAT -1
#endif
#define REP(k) for (int rep_ = 0; rep_ < ((PROBE_REPEAT == (k)) ? 2 : 1); ++rep_)
    if (IN(0)) { REP(0) { if (rep_) xcd_barrier(bar); p0_prologue(p, lds, G, bid); } }
    SEAM(0);
    if (IN(1)) {
#if PROBE_REPEAT == 13
        { EpiProj E{(bf16_t*)(ws + WS_Q), (const f32x2*)(ws + WS_ROPE)}; Gemm g{(const bf16_t*)(ws + WS_XN), (const bf16_t*)(ws + WS_W1), M, NPROJ, DM}; StaticOrder S; S.init(M, NPROJ, G, bid); gemm_phase<EpiProj, StaticOrder, true, true>(lds, g, S, E); xcd_barrier(bar); }
#elif PROBE_REPEAT == 14
        { EpiNull E{}; Gemm g{(const bf16_t*)(ws + WS_XN), (const bf16_t*)(ws + WS_W1), M, NPROJ, DM}; StaticOrder S; S.init(M, NPROJ, G, bid); gemm_phase<EpiNull, StaticOrder, true, true>(lds, g, S, E); xcd_barrier(bar); }
#endif
    }
    if (IN(1)) { REP(1) { if (rep_) xcd_barrier(bar); EpiProj E{(bf16_t*)(ws + WS_Q), (const f32x2*)(ws + WS_ROPE)};
                 Gemm g{(const bf16_t*)(ws + WS_XN), (const bf16_t*)(ws + WS_W1), M, NPROJ, DM}; StaticOrder S; S.init(M, NPROJ, G, bid); gemm_phase<EpiProj, StaticOrder, true, true>(lds, g, S, E); } }
    SEAM(1);
    if (IN(2)) { REP(2) { if (rep_) xcd_barrier(bar); p2_tseg(p, lds, G, bid); p2_gmlp(p, lds, G, bid); }
#if PROBE_REPEAT == 8
                 xcd_barrier(bar); p2_tseg(p, lds, G, bid);
#elif PROBE_REPEAT == 9
                 xcd_barrier(bar); p2_gmlp(p, lds, G, bid);
#endif
    }
    SEAM(2);
    if (IN(3)) { REP(3) { if (rep_) xcd_barrier(bar); p3_retention(p, lds, G, bid); } }
    SEAM(3);
    if (IN(4)) { REP(4) { if (rep_) xcd_barrier(bar); EpiResid<true> E{p.in[0], (bf16_t*)(ws + WS_XN), (float*)(ws + WS_SS1), (LAS float*)(lds + 131072)};
                 Gemm g{(const bf16_t*)(ws + WS_MIX), (const bf16_t*)(ws + WS_W4), M, DM, DM}; StaticOrder S; S.init(M, DM, G, bid); gemm_phase<EpiResid<true>, StaticOrder, true, true>(lds, g, S, E); } }
    SEAM(4);
    if (IN(5)) {
#if PROBE_REPEAT == 10
        { EpiNull E{}; Gemm g{(const bf16_t*)(ws + WS_XN), (const bf16_t*)(ws + WS_W5), M, NFF2, DM}; StaticOrder S; S.init(M, NFF2, G, bid); gemm_phase<EpiNull, StaticOrder, true, true>(lds, g, S, E); xcd_barrier(bar); }
#elif PROBE_REPEAT == 11
        { EpiSwiglu E{(bf16_t*)(ws + WS_HID), (const float*)(ws + WS_SS1)}; Gemm g{(const bf16_t*)(ws + WS_XN), (const bf16_t*)(ws + WS_W5), M, NFF2, DM}; StaticOrder S; S.init(M, NFF2, G, bid); gemm_phase<EpiSwiglu, StaticOrder, true, true>(lds, g, S, E); xcd_barrier(bar); }
#elif PROBE_REPEAT == 12
        { EpiNull E{}; Gemm g{(const bf16_t*)(ws + WS_HID), (const bf16_t*)(ws + WS_W6), M, DM, DFF}; StaticOrder S; S.init(M, DM, G, bid); gemm_phase<EpiNull, StaticOrder, true, true>(lds, g, S, E); xcd_barrier(bar); }
#endif
    }
    if (IN(5)) { REP(5) { if (rep_) xcd_barrier(bar); EpiSwiglu E{(bf16_t*)(ws + WS_HID), (const float*)(ws + WS_SS1)};
                 Gemm g{(const bf16_t*)(ws + WS_XN), (const bf16_t*)(ws + WS_W5), M, NFF2, DM}; StaticOrder S; S.init(M, NFF2, G, bid); gemm_phase<EpiSwiglu, StaticOrder, true, true>(lds, g, S, E); } }
    SEAM(5);
    if (IN(6)) {
#if PROBE_REPEAT == 6
        { EpiResid<false> E{(const void*)(ws + WS_XN), (bf16_t*)(ws + WS_MIX), (float*)(ws + WS_SS2), (LAS float*)(lds + 131072)};
          Gemm g{(const bf16_t*)(ws + WS_HID), (const bf16_t*)(ws + WS_W6), M, DM, DFF}; StaticOrder S; S.init(M, DM, G, bid); gemm_phase<EpiResid<false>, StaticOrder, true, true>(lds, g, S, E); xcd_barrier(bar); }
#endif
        EpiResid<false> E{(const void*)(ws + WS_XN), (bf16_t*)(ws + WS_MIX), (float*)(ws + WS_SS2), (LAS float*)(lds + 131072)};
        Gemm g{(const bf16_t*)(ws + WS_HID), (const bf16_t*)(ws + WS_W6), M, DM, DFF}; StaticOrder S; S.init(M, DM, G, bid); gemm_phase<EpiResid<false>, StaticOrder, true, true>(lds, g, S, E); }
    SEAM(6);
    if (IN(7)) {
#if PROBE_REPEAT == 7
        p7_final(p, G, bid, (float*)(ws + WS_Q)); xcd_barrier(bar);
#endif
        p7_final(p, G, bid, p.out); }
#undef IN
#undef SEAM
}

extern "C" void kernel_launch(void* const* d_in, const int* in_sizes, int n_in, void* d_out, int out_size, void* d_ws, size_t ws_size, hipStream_t stream) {
    static int grid = 0;
    if (grid == 0) {
        if (n_in != 14 || in_sizes[0] != M * DM || out_size != M * DM || ws_size < WS_END) { fprintf(stderr, "kernel_launch: unexpected shapes (n_in %d, in0 %d, out %d, ws %zu)\n", n_in, n_in > 0 ? in_sizes[0] : -1, out_size, ws_size); grid = -1; return; }
        int dev = 0, cus = 0, per_cu = 0;
        (void)hipGetDevice(&dev); (void)hipDeviceGetAttribute(&cus, hipDeviceAttributeMultiprocessorCount, dev);
        (void)hipFuncSetAttribute((const void*)fwd_kernel, hipFuncAttributeMaxDynamicSharedMemorySize, LDS_BYTES);
        (void)hipOccupancyMaxActiveBlocksPerMultiprocessor(&per_cu, (const void*)fwd_kernel, 512, LDS_BYTES);
        if (per_cu < 1) { fprintf(stderr, "kernel_launch: occupancy query says %d blocks per CU\n", per_cu); per_cu = 1; }
        if (per_cu > 1) per_cu = 1;
        grid = cus * per_cu;
        (void)hipGetLastError();
    }
    if (grid < 0) return;
    if (hipMemsetAsync(d_ws, 0, 16384, stream) != hipSuccess) { fprintf(stderr, "kernel_launch: memset of the barrier words failed\n"); return; }
    Params p{};
    for (int i = 0; i < 14; ++i) p.in[i] = (const float*)d_in[i];
    p.out = (float*)d_out; p.ws = (unsigned char*)d_ws;
    const int per = NPHASE / N_LAUNCHES;
    for (int li = 0; li < N_LAUNCHES; ++li) {
        p.ph_lo = li * per; p.ph_hi = (li == N_LAUNCHES - 1) ? NPHASE : (li + 1) * per;
        void* args[] = {&p};
        hipError_t e = hipLaunchCooperativeKernel((const void*)fwd_kernel, dim3(grid), dim3(512), args, LDS_BYTES, stream);
        if (e != hipSuccess) { fprintf(stderr, "kernel_launch: cooperative launch %d failed: %s (grid %d)\n", li, hipGetErrorString(e), grid); break; }
    }
}
```
